# Optimizing an MI355X kernel written in HIP

```python
import jax, jax.numpy as jnp
from jax import lax
import numpy as np

D_MODEL = 4096
BATCH = 4
SEQ = 2048
DEPTH = 1
DEC_BATCH = 128
DEC_SEQ = 1
PAST_LEN = 16384
PAGE_SIZE = 128

D_MIX = D_MODEL
D_POOL = D_MIX // 4
POOL_WINDOWS = (2, 4, 8, 16)
N_POOL_GROUPS = len(POOL_WINDOWS)
POOL_GROUP = D_POOL // N_POOL_GROUPS
POOL_STATE = max(POOL_WINDOWS) - 1
GLA_HEADS = 4
D_GLA_V = D_MIX - D_POOL
DV_HEAD = D_GLA_V // GLA_HEADS
DK_HEAD = DV_HEAD // 2
D_GLA_K = GLA_HEADS * DK_HEAD
GATE_RANK = 16
GATE_NORM = 16.0
GLA_CHUNK = 64
D_IN = D_POOL + 2 * D_GLA_K + 2 * D_GLA_V + GATE_RANK
D_FF = ((8 * D_MODEL // 3 + 255) // 256) * 256
N_MOD = 6
EPS = 1e-6

kernel_name = "pool_gla_hybrid_adaln_step"


def rmsnorm(x, gain):
    xf = x.astype(jnp.float32)
    y = xf * lax.rsqrt(jnp.mean(xf * xf, axis=-1, keepdims=True) + EPS)
    return (y * gain.astype(jnp.float32)).astype(x.dtype)


def multiscale_pool(buf, pos):
    P = POOL_STATE
    B, L, C = buf.shape
    T = L - P
    bf = buf.astype(jnp.float32)
    cs = jnp.concatenate([jnp.zeros((B, 1, C), jnp.float32), jnp.cumsum(bf, axis=1)], axis=1)
    outs = []
    for gi, w in enumerate(POOL_WINDOWS):
        lo, hi = gi * POOL_GROUP, (gi + 1) * POOL_GROUP
        win_sum = cs[:, P + 1:P + T + 1, lo:hi] - cs[:, P + 1 - w:P + T + 1 - w, lo:hi]
        cnt = jnp.minimum(w, pos + 1).astype(jnp.float32)[None, :, None]
        outs.append(win_sum / cnt - bf[:, P:, lo:hi])
    return jnp.concatenate(outs, axis=-1).astype(buf.dtype)


def pool_mixer(u, prefix, pos, w_pool, pool_scale):
    buf = jnp.concatenate([prefix.astype(u.dtype), u], axis=1)
    d = multiscale_pool(buf, pos)
    B, T = d.shape[:2]
    y = jnp.einsum('btgc,gcd->btgd', d.reshape(B, T, N_POOL_GROUPS, POOL_GROUP), w_pool)
    y = y.reshape(B, T, D_POOL) * pool_scale
    return y, buf[:, -POOL_STATE:]


def gla_recurrence(q, k, v, log_a, s0):
    B, T, H, _ = q.shape
    DV = v.shape[-1]
    C = min(GLA_CHUNK, T)
    n = -(-T // C)
    pad = n * C - T

    def blocks(t):
        t = jnp.pad(t.astype(jnp.float32), ((0, 0), (0, pad), (0, 0), (0, 0)))
        return t.reshape(B, n, C, H, t.shape[-1]).transpose(1, 0, 3, 2, 4)

    mask = jnp.tril(jnp.ones((C, C), dtype=bool))[:, :, None]

    def step(S, inp):
        qc, kc, vc, ac = inp
        b = jnp.cumsum(ac, axis=2)
        o_inter = jnp.einsum('bhid,bhde->bhie', qc * jnp.exp(b), S)
        diff = b[:, :, :, None, :] - b[:, :, None, :, :]
        decay = jnp.where(mask, jnp.exp(jnp.minimum(diff, 0.0)), 0.0)
        scores = jnp.einsum('bhid,bhijd,bhjd->bhij', qc, decay, kc)
        o_intra = jnp.einsum('bhij,bhje->bhie', scores, vc)
        b_last = b[:, :, -1, :]
        S_new = jnp.exp(b_last)[..., None] * S + jnp.einsum(
            'bhjd,bhje->bhde', kc * jnp.exp(b_last[:, :, None, :] - b), vc)
        return S_new, o_inter + o_intra

    S, o = lax.scan(step, s0.astype(jnp.float32), (blocks(q), blocks(k), blocks(v), blocks(log_a)))
    o = o.transpose(1, 0, 3, 2, 4).reshape(B, n * C, H, DV)[:, :T]
    return o, S


def decoder_layer(x, c, pool_prefix, gla_s0, pos, w_ada, b_ada, g_norm1, w_in, w_pool, pool_scale,
                  w_a2, b_a, g_gla_out, w_out, g_norm2, w_ff1, w_ff3, w_ff2):
    B, T, _ = x.shape
    mod = (jax.nn.silu(c) @ w_ada + b_ada)[:, None, :]
    sh1, sc1, gt1, sh2, sc2, gt2 = jnp.split(mod, N_MOD, axis=-1)
    h = rmsnorm(x, g_norm1) * (1 + sc1) + sh1
    z = h @ w_in
    s1 = D_POOL
    s2 = s1 + D_GLA_K
    s3 = s2 + D_GLA_K
    s4 = s3 + D_GLA_V
    s5 = s4 + D_GLA_V
    u, q, k, v, g, a_lr = jnp.split(z, [s1, s2, s3, s4, s5], axis=-1)
    pool_y, pool_state = pool_mixer(u, pool_prefix, pos, w_pool, pool_scale)
    log_a = jax.nn.log_sigmoid((a_lr @ w_a2 + b_a).astype(jnp.float32)) / GATE_NORM
    qh = q.reshape(B, T, GLA_HEADS, DK_HEAD) * (DK_HEAD ** -0.5)
    kh = k.reshape(B, T, GLA_HEADS, DK_HEAD)
    vh = v.reshape(B, T, GLA_HEADS, DV_HEAD)
    ah = log_a.reshape(B, T, GLA_HEADS, DK_HEAD)
    o, gla_state = gla_recurrence(qh, kh, vh, ah, gla_s0)
    o = rmsnorm(o.astype(x.dtype), g_gla_out).reshape(B, T, D_GLA_V)
    o = jax.nn.silu(g) * o
    mix = jnp.concatenate([pool_y, o], axis=-1) @ w_out
    x = x + gt1 * mix
    h2 = rmsnorm(x, g_norm2) * (1 + sc2) + sh2
    ff = (jax.nn.silu(h2 @ w_ff1) * (h2 @ w_ff3)) @ w_ff2
    x = x + gt2 * ff
    return x, pool_state, gla_state.astype(gla_s0.dtype)


def setup_inputs(seed: int = 0) -> dict:
    key = jax.random.key(seed)
    ks = jax.random.split(key, 24)
    L = DEPTH

    def nrm(k, shape, s):
        return jax.random.normal(k, shape, jnp.float32) * s

    return {
        "x_prompt": nrm(ks[0], (BATCH, SEQ, D_MODEL), 1.0),
        "x_sample": nrm(ks[1], (DEC_BATCH, DEC_SEQ, D_MODEL), 1.0),
        "state_pool": nrm(ks[2], (L, DEC_BATCH, POOL_STATE, D_POOL), 1.0),
        "state_gla": nrm(ks[3], (L, DEC_BATCH, GLA_HEADS, DK_HEAD, DV_HEAD), 0.5),
        "c_prompt": nrm(ks[4], (BATCH, D_MODEL), 1.0),
        "c_sample": nrm(ks[5], (DEC_BATCH, D_MODEL), 1.0),
        "w_ada": nrm(ks[6], (L, D_MODEL, N_MOD * D_MODEL), 0.5 * D_MODEL ** -0.5),
        "b_ada": nrm(ks[7], (L, N_MOD * D_MODEL), 0.02),
        "g_norm1": 1.0 + nrm(ks[8], (L, D_MODEL), 0.05),
        "w_in": nrm(ks[9], (L, D_MODEL, D_IN), D_MODEL ** -0.5),
        "w_pool": nrm(ks[10], (L, N_POOL_GROUPS, POOL_GROUP, POOL_GROUP), POOL_GROUP ** -0.5),
        "pool_scale": 1.0 + nrm(ks[11], (L, D_POOL), 0.1),
        "w_a2": nrm(ks[12], (L, GATE_RANK, D_GLA_K), GATE_RANK ** -0.5),
        "b_a": nrm(ks[13], (L, D_GLA_K), 0.1),
        "g_gla_out": 1.0 + nrm(ks[14], (L, GLA_HEADS, DV_HEAD), 0.05),
        "w_out": nrm(ks[15], (L, D_MIX, D_MODEL), D_MIX ** -0.5),
        "g_norm2": 1.0 + nrm(ks[16], (L, D_MODEL), 0.05),
        "w_ff1": nrm(ks[17], (L, D_MODEL, D_FF), D_MODEL ** -0.5),
        "w_ff3": nrm(ks[18], (L, D_MODEL, D_FF), D_MODEL ** -0.5),
        "w_ff2": nrm(ks[19], (L, D_FF, D_MODEL), D_FF ** -0.5),
        "g_final": 1.0 + nrm(ks[20], (D_MODEL,), 0.05),
    }


def reference(x_prompt, x_sample, state_pool, state_gla, c_prompt, c_sample, w_ada, b_ada, g_norm1,
              w_in, w_pool, pool_scale, w_a2, b_a, g_gla_out, w_out, g_norm2, w_ff1, w_ff3, w_ff2,
              g_final):
    Bp, Tp, _ = x_prompt.shape
    Ts = x_sample.shape[1]
    pos_p = jnp.arange(Tp, dtype=jnp.int32)
    pos_s = PAST_LEN + jnp.arange(Ts, dtype=jnp.int32)
    h_p, h_s = x_prompt, x_sample
    pool_p_list, gla_p_list, pool_s_list, gla_s_list = [], [], [], []
    for l in range(DEPTH):
        lw = (w_ada[l], b_ada[l], g_norm1[l], w_in[l], w_pool[l], pool_scale[l], w_a2[l], b_a[l],
              g_gla_out[l], w_out[l], g_norm2[l], w_ff1[l], w_ff3[l], w_ff2[l])
        pool_prefix0 = jnp.zeros((Bp, POOL_STATE, D_POOL), x_prompt.dtype)
        gla_s00 = jnp.zeros((Bp, GLA_HEADS, DK_HEAD, DV_HEAD), state_gla.dtype)
        h_p, pool_p, gla_p = decoder_layer(h_p, c_prompt, pool_prefix0, gla_s00, pos_p, *lw)
        h_s, pool_s, gla_s = decoder_layer(h_s, c_sample, state_pool[l], state_gla[l], pos_s, *lw)
        pool_p_list.append(pool_p)
        gla_p_list.append(gla_p)
        pool_s_list.append(pool_s.astype(state_pool.dtype))
        gla_s_list.append(gla_s)
    y_prompt = rmsnorm(h_p, g_final)
    y_sample = rmsnorm(h_s, g_final)
    new_pool_prompt = jnp.stack(pool_p_list)
    new_gla_prompt = jnp.stack(gla_p_list)
    new_pool_sample = jnp.stack(pool_s_list)
    new_gla_sample = jnp.stack(gla_s_list)
    return (y_prompt, y_sample, new_pool_prompt, new_gla_prompt, new_pool_sample, new_gla_sample)
```

```cpp
#include <hip/hip_runtime.h>
#include <cstdio>
#include <cstdint>

#ifndef PROBE_DUP
#define PROBE_DUP 0
#endif
#ifndef MK_LAUNCHES
#define MK_LAUNCHES 1
#endif

namespace pg8 {
#define PG8_LAS __attribute__((address_space(3)))
typedef unsigned short bf16_t;
typedef short bf16x8 __attribute__((ext_vector_type(8)));
typedef float f32x4 __attribute__((ext_vector_type(4)));
typedef unsigned u32x4 __attribute__((ext_vector_type(4)));
constexpr int BM = 256, BK = 64, HALF = 128, HTB = HALF * BK * 2  , STAGE_BYTES = 8 * HTB, NXCD = 8, WGM = 8;

__host__ __device__ __forceinline__ int lds_byte(int r, int c) { const int st = (r >> 4) * 2 + (c >> 5), rr = r & 15, cc = c & 31, ob = rr * 64 + cc * 2; return st * 1024 + (ob ^ (((ob >> 9) & 1) << 5)); }
__host__ __device__ __forceinline__ void stage_rc(int b, int& R, int& C) { const int st = b / 1024, sb = b % 1024, swz = sb ^ (((sb >> 9) & 1) << 5); R = (st >> 1) * 16 + swz / 64; C = (st & 1) * 32 + (swz % 64) / 2; }
__host__ __device__ __forceinline__ int perm32(int rho) { const int n = rho >> 4, i = rho & 15; return 8 * (i >> 2) + 4 * n + (i & 3); }

struct Unit { int pm, pn, kb, nkt, ks; bool half, ksp; };
struct Gemm { const bf16_t* A; const bf16_t* Bt; int lda, ldb, a_pn_off; };

struct TwoPartOrder {
    int nMp, nN, nP, nS, G, c, KT, nks, kt_a, kt_b, n_a, early, ovf;
    __host__ __device__ void init(int nMp_, int nN_, int KT_, int nks_, int kt_a_, int kt_b_, int n_a_, int G_, int c_, int early_ = 0) {
        early = early_; ovf = 0; nMp = nMp_; nN = nN_; nP = nMp * nN; KT = KT_; nks = nks_; kt_a = kt_a_; kt_b = kt_b_; n_a = n_a_; nS = nN * nks; G = G_; c = c_; }
    __host__ __device__ bool next(int i, Unit& u) const {
        if (early && (c & 1)) {
            if (i == 0) { u.pm = nMp; u.pn = c % nN; u.ks = c / nN; u.half = true; u.ksp = false; u.kb = u.ks < n_a ? u.ks * kt_a : n_a * kt_a + (u.ks - n_a) * kt_b; u.nkt = u.ks < n_a ? kt_a : kt_b; return true; }
            i -= 1;
            if ((long)i * G + c >= nP) return false;
        }
        const long L = (long)i * G + c;
        if (L < nP) {
            int wgid = (int)L; { const int q = nP / NXCD, r = nP % NXCD, xcd = wgid % NXCD, off = wgid / NXCD; wgid = (xcd < r ? xcd * (q + 1) : r * (q + 1) + (xcd - r) * q) + off; }
            const int nig = WGM * nN, gid = wgid / nig, fm = gid * WGM, gsz = (nMp - fm) < WGM ? (nMp - fm) : WGM;
            u.pm = fm + ((wgid % nig) % gsz); u.pn = (wgid % nig) / gsz; u.kb = 0; u.nkt = KT; u.ks = 0; u.half = false; u.ksp = false; return true;
        }
        const int shift = nP % G, i0 = nP / G, m = i - i0, cr = (c - shift + G) % G;
        if (ovf > 0 && m >= 1) {
            const int J0 = G - shift, q = (m - 1) * G + c;
            if (q >= (nS - J0) * ovf) return false;
            const int k = q / ovf, nh = (nS - J0) / 2;
            u.pm = nMp; u.pn = k < nh ? nN / 2 - nh + k : nN - 2 * nh + k; u.ks = q % ovf; u.half = true; u.ksp = true; u.nkt = KT / ovf; u.kb = u.ks * u.nkt; return true;
        }
        const int j = (m == 0) ? cr : (G - shift) + (m - 1) * G + cr;
        if (j >= nS) return false;
        u.pm = nMp; u.pn = j % nN; u.ks = j / nN; u.half = true; u.ksp = false;
        if (ovf > 0) { const int nh = (nS - (G - shift)) / 2; u.pn = j < nN / 2 - nh ? j : j + nh; }
        u.kb = u.ks < n_a ? u.ks * kt_a : n_a * kt_a + (u.ks - n_a) * kt_b; u.nkt = u.ks < n_a ? kt_a : kt_b; return true;
    }
    __device__ __forceinline__ void a_ready(const Unit&) const {}
    __device__ __forceinline__ void done(const Unit&) const {}
};

__device__ __forceinline__ unsigned cvt_pk_bf16(float lo, float hi) { unsigned r; asm volatile("v_cvt_pk_bf16_f32 %0, %1, %2" : "=v"(r) : "v"(lo), "v"(hi)); return r; }
__device__ __forceinline__ float silu_f(float x) { return x * __builtin_amdgcn_rcpf(1.0f + __expf(-x)); }

struct EpiZ {
    static constexpr bool PERM = true, AFTER_DRAIN = false;
    bf16_t* O; int ldc; float* slab;
    __device__ __forceinline__ void operator()(const f32x4 (&acc)[2][2][4][2], const Unit& u, int wr, int wc, int fr, int fq) const {
        const int row0 = u.pm * BM + wr * 64 + fr, col0 = u.pn * BM + wc * 32 + 8 * fq;
        if (!u.half) {
#pragma unroll
            for (int ai = 0; ai < 2; ++ai)
#pragma unroll
                for (int m = 0; m < 4; ++m) { bf16_t* rowp = O + (size_t)(row0 + ai * HALF + m * 16) * ldc + col0;
#pragma unroll
                    for (int bj = 0; bj < 2; ++bj) { const f32x4 v0 = acc[ai][bj][m][0], v1 = acc[ai][bj][m][1];
                        u32x4 w; w.x = cvt_pk_bf16(v0[0], v0[1]); w.y = cvt_pk_bf16(v0[2], v0[3]); w.z = cvt_pk_bf16(v1[0], v1[1]); w.w = cvt_pk_bf16(v1[2], v1[3]);
                        *(u32x4*)(rowp + bj * HALF) = w; } }
        } else {
#pragma unroll
            for (int m = 0; m < 4; ++m) { float* rowp = slab + ((size_t)u.ks * 128 + (wr * 64 + fr + m * 16)) * ldc + col0;
#pragma unroll
                for (int bj = 0; bj < 2; ++bj) { *(f32x4*)(rowp + bj * HALF) = acc[0][bj][m][0]; *(f32x4*)(rowp + bj * HALF + 4) = acc[0][bj][m][1]; } }
        }
    }
};
struct EpiPool {
    static constexpr bool PERM = true, AFTER_DRAIN = false;
    bf16_t* O; int ldc; const float* scale;
    __device__ __forceinline__ void operator()(const f32x4 (&acc)[2][2][4][2], const Unit& u, int wr, int wc, int fr, int fq) const {
        const int row0 = u.pm * BM + wr * 64 + fr, col0 = u.pn * BM + wc * 32 + 8 * fq;
        f32x4 sv[2][2];
#pragma unroll
        for (int bj = 0; bj < 2; ++bj)
#pragma unroll
            for (int n = 0; n < 2; ++n) sv[bj][n] = *(const f32x4*)(scale + col0 + bj * HALF + 4 * n);
#pragma unroll
        for (int ai = 0; ai < 2; ++ai)
#pragma unroll
            for (int m = 0; m < 4; ++m) { bf16_t* rowp = O + (size_t)(row0 + ai * HALF + m * 16) * ldc + col0;
#pragma unroll
                for (int bj = 0; bj < 2; ++bj) { const f32x4 v0 = acc[ai][bj][m][0] * sv[bj][0], v1 = acc[ai][bj][m][1] * sv[bj][1];
                    u32x4 w; w.x = cvt_pk_bf16(v0[0], v0[1]); w.y = cvt_pk_bf16(v0[2], v0[3]); w.z = cvt_pk_bf16(v1[0], v1[1]); w.w = cvt_pk_bf16(v1[2], v1[3]);
                    *(u32x4*)(rowp + bj * HALF) = w; } }
    }
};
struct EpiSwiGLU {
    static constexpr bool PERM = true, AFTER_DRAIN = false;
    bf16_t* O; int ldc; float* slab; int psplit, pa, pb, lds_;
    __device__ __forceinline__ void operator()(const f32x4 (&acc)[2][2][4][2], const Unit& u, int wr, int wc, int fr, int fq) const {
        const int row0 = u.pm * BM + wr * 64 + fr, col0 = u.pn * HALF + wc * 32 + 8 * fq;
        if (!u.ksp) {
#pragma unroll
            for (int ai = 0; ai < 2; ++ai) {
                if (ai == 1 && u.half) break;
#pragma unroll
                for (int m = 0; m < 4; ++m) { bf16_t* rowp = O + (size_t)(row0 + ai * HALF + m * 16) * ldc + col0;
                    const f32x4 a0 = acc[ai][0][m][0], a1 = acc[ai][0][m][1], b0 = acc[ai][1][m][0], b1 = acc[ai][1][m][1];
                    float o[8];
#pragma unroll
                    for (int j = 0; j < 4; ++j) { o[j] = silu_f(a0[j]) * b0[j]; o[4 + j] = silu_f(a1[j]) * b1[j]; }
                    u32x4 w; w.x = cvt_pk_bf16(o[0], o[1]); w.y = cvt_pk_bf16(o[2], o[3]); w.z = cvt_pk_bf16(o[4], o[5]); w.w = cvt_pk_bf16(o[6], o[7]);
                    *(u32x4*)rowp = w; } }
        } else {
            const int cs = (u.pn - (u.pn < psplit ? pa : pb)) * HALF + wc * 32 + 8 * fq;
#pragma unroll
            for (int m = 0; m < 4; ++m)
#pragma unroll
                for (int bj = 0; bj < 2; ++bj) { float* rowp = slab + ((size_t)(u.ks * 2 + bj) * 128 + (wr * 64 + fr + m * 16)) * lds_ + cs;
                    *(f32x4*)rowp = acc[0][bj][m][0]; *(f32x4*)(rowp + 4) = acc[0][bj][m][1]; }
        }
    }
};
template <bool XBF>
struct EpiResB {
    static constexpr bool PERM = true, AFTER_DRAIN = false;
    const float* xf; const bf16_t* xb; const float* gate;
    bf16_t* O; float* slab;
    __device__ __forceinline__ void operator()(const f32x4 (&acc)[2][2][4][2], const Unit& u, int wr, int wc, int fr, int fq) const {
        const int row0 = u.pm * BM + wr * 64 + fr, col0 = u.pn * BM + wc * 32 + 8 * fq;
        if (!u.half) {
            const float* gr = gate + (size_t)((u.pm * BM) >> 11) * 24576 + col0;
            f32x4 gv[2][2];
#pragma unroll
            for (int bj = 0; bj < 2; ++bj)
#pragma unroll
                for (int n = 0; n < 2; ++n) gv[bj][n] = *(const f32x4*)(gr + bj * HALF + 4 * n);
#pragma unroll
            for (int ai = 0; ai < 2; ++ai)
#pragma unroll
                for (int m = 0; m < 4; ++m) { const int row = row0 + ai * HALF + m * 16;
                    bf16_t* orow = O + (size_t)row * 4096 + col0;
                    f32x4 xv[2][2];
                    if (XBF) { const bf16_t* xr = xb + (size_t)row * 4096 + col0;
#pragma unroll
                        for (int bj = 0; bj < 2; ++bj) { const u32x4 w = *(const u32x4*)(xr + bj * HALF);
                            xv[bj][0] = (f32x4){__uint_as_float(w.x << 16), __uint_as_float(w.x & 0xffff0000u), __uint_as_float(w.y << 16), __uint_as_float(w.y & 0xffff0000u)};
                            xv[bj][1] = (f32x4){__uint_as_float(w.z << 16), __uint_as_float(w.z & 0xffff0000u), __uint_as_float(w.w << 16), __uint_as_float(w.w & 0xffff0000u)}; }
                    } else { const float* xr = xf + (size_t)row * 4096 + col0;
#pragma unroll
                        for (int bj = 0; bj < 2; ++bj)
#pragma unroll
                            for (int n = 0; n < 2; ++n) xv[bj][n] = *(const f32x4*)(xr + bj * HALF + 4 * n); }
#pragma unroll
                    for (int bj = 0; bj < 2; ++bj) { const f32x4 v0 = xv[bj][0] + gv[bj][0] * acc[ai][bj][m][0], v1 = xv[bj][1] + gv[bj][1] * acc[ai][bj][m][1];
                        u32x4 w; w.x = cvt_pk_bf16(v0[0], v0[1]); w.y = cvt_pk_bf16(v0[2], v0[3]); w.z = cvt_pk_bf16(v1[0], v1[1]); w.w = cvt_pk_bf16(v1[2], v1[3]);
                        *(u32x4*)(orow + bj * HALF) = w; }
                    if (m & 1) asm volatile("" ::: "memory"); }
        } else {
#pragma unroll
            for (int m = 0; m < 4; ++m) { float* rowp = slab + ((size_t)u.ks * 128 + (wr * 64 + fr + m * 16)) * 4096 + col0;
#pragma unroll
                for (int bj = 0; bj < 2; ++bj) { *(f32x4*)(rowp + bj * HALF) = acc[0][bj][m][0]; *(f32x4*)(rowp + bj * HALF + 4) = acc[0][bj][m][1]; } }
        }
    }
};

template <class Epi, class Sched, bool ALIGN_EPI = false, bool SP2 = false>
__device__ __forceinline__ void gemm_phase(PG8_LAS unsigned char* lds, const Gemm g, const Sched& S, const Epi& E) {
    const int tid = threadIdx.x, wid = __builtin_amdgcn_readfirstlane(tid >> 6), lane = tid & 63, wr = wid >> 2, wc = wid & 3, fr = lane & 15, fq = lane >> 4;
    unsigned voffA[2], voffB[2];
#pragma unroll
    for (int i = 0; i < 2; ++i) { int R, C; stage_rc(tid * 16 + i * 8192, R, C); const int Rb = Epi::PERM ? ((R & ~31) + perm32(R & 31)) : R;
        voffA[i] = (unsigned)(R * g.lda + C) * 2u; voffB[i] = (unsigned)(Rb * g.ldb + C) * 2u; }
    const size_t kstep = (size_t)(BK * 2);
    const size_t hstepA = (size_t)HALF * g.lda * 2, hstepB = (size_t)HALF * g.ldb * 2;
    const size_t tstepA = 2 * hstepA, tstepB = 2 * hstepB;
    const unsigned ldsw = (unsigned)wid * 1024u;
    const int aoff = lds_byte(wr * 64 + fr, fq * 8), boff = lds_byte(wc * 32 + fr, fq * 8);
#define PG8_SA(b, h) (((b) * 2 + (h)) * HTB)
#define PG8_SB(b, h) ((4 + (b) * 2 + (h)) * HTB)
#define PG8_STAGE(bufoff, gbase, voff) do { _Pragma("unroll") for (int _i = 0; _i < 2; ++_i) \
        __builtin_amdgcn_global_load_lds((const unsigned*)((const char*)(gbase) + (voff)[_i]), (PG8_LAS unsigned*)(lds + (bufoff) + ldsw + _i * 8192), 16, 0, 0); } while (0)
#define PG8_LDA(dst, b, h) do { _Pragma("unroll") for (int m = 0; m < 4; ++m) _Pragma("unroll") for (int k = 0; k < 2; ++k) dst[m][k] = *(const PG8_LAS bf16x8*)(lds + PG8_SA(b, h) + aoff + m * 2048 + k * 1024); } while (0)
#define PG8_LDB(dst, b, h) do { _Pragma("unroll") for (int n = 0; n < 2; ++n) _Pragma("unroll") for (int k = 0; k < 2; ++k) dst[n][k] = *(const PG8_LAS bf16x8*)(lds + PG8_SB(b, h) + boff + n * 2048 + k * 1024); } while (0)
#define PG8_MMA(ai, bj, At, Bt) do { __builtin_amdgcn_s_setprio(1); _Pragma("unroll") for (int m = 0; m < 4; ++m) _Pragma("unroll") for (int n = 0; n < 2; ++n) _Pragma("unroll") for (int k = 0; k < 2; ++k) \
        acc[ai][bj][m][n] = __builtin_amdgcn_mfma_f32_16x16x32_bf16(Bt[n][k], At[m][k], acc[ai][bj][m][n], 0, 0, 0); __builtin_amdgcn_s_setprio(0); } while (0)
#define PG8_WAIT_V(n) asm volatile("s_waitcnt vmcnt(" #n ")" ::: "memory")
#define PG8_WAIT_L(n) asm volatile("s_waitcnt lgkmcnt(" #n ")" ::: "memory")
#define PG8_BAR __builtin_amdgcn_s_barrier()
#define PG8_SCHED __builtin_amdgcn_sched_barrier(0)
    Unit cur, nxt; int ui = 0;
    if (!S.next(0, cur)) return;
    f32x4 acc[2][2][4][2];
#pragma unroll
    for (int a = 0; a < 2; ++a)
#pragma unroll
        for (int b = 0; b < 2; ++b)
#pragma unroll
            for (int m = 0; m < 4; ++m)
#pragma unroll
                for (int n = 0; n < 2; ++n) acc[a][b][m][n] = (f32x4){0.f, 0.f, 0.f, 0.f};
    bf16x8 At[4][2], B0[2][2], B1[2][2];
    const char* cA = (const char*)g.A + (size_t)cur.pm * tstepA + (size_t)cur.pn * (size_t)g.a_pn_off * 2 + (size_t)cur.kb * kstep; const char* cB = (const char*)g.Bt + (size_t)cur.pn * tstepB + (size_t)cur.kb * kstep;
    S.a_ready(cur);
    if constexpr (SP2) {
        PG8_STAGE(PG8_SB(0, 0), cB, voffB); PG8_STAGE(PG8_SB(0, 1), cB + hstepB, voffB); PG8_STAGE(PG8_SA(0, 0), cA, voffA); PG8_STAGE(PG8_SA(0, 1), cA + hstepA, voffA);
        if (wr == 1) PG8_BAR;
        PG8_WAIT_V(2); PG8_BAR;
        PG8_STAGE(PG8_SB(1, 0), cB + kstep, voffB); PG8_STAGE(PG8_SA(1, 0), cA + kstep, voffA); PG8_STAGE(PG8_SB(1, 1), cB + hstepB + kstep, voffB);
        PG8_WAIT_V(6); PG8_BAR;
    } else {
        PG8_STAGE(PG8_SB(0, 0), cB, voffB); PG8_STAGE(PG8_SA(0, 0), cA, voffA); PG8_STAGE(PG8_SB(0, 1), cB + hstepB, voffB); PG8_STAGE(PG8_SA(0, 1), cA + hstepA, voffA);
        if (wr == 1) PG8_BAR;
        PG8_WAIT_V(4); PG8_BAR;
        PG8_STAGE(PG8_SB(1, 0), cB + kstep, voffB); PG8_STAGE(PG8_SA(1, 0), cA + kstep, voffA); PG8_STAGE(PG8_SB(1, 1), cB + hstepB + kstep, voffB);
        PG8_WAIT_V(6); PG8_BAR;
    }
    for (;;) {
        const bool has_next = S.next(ui + 1, nxt);
        const char* nA = has_next ? (const char*)g.A + (size_t)nxt.pm * tstepA + (size_t)nxt.pn * (size_t)g.a_pn_off * 2 + (size_t)nxt.kb * kstep : cA; const char* nB = has_next ? (const char*)g.Bt + (size_t)nxt.pn * tstepB + (size_t)nxt.kb * kstep : cB;
        const int nt = cur.nkt; const bool full = !cur.half;
        for (int t = 0; t < nt; t += 2) {
            const bool last = (t == nt - 2);
            const char* a1 = cA + (size_t)(t + 1) * kstep;
            const char* a2 = last ? nA : cA + (size_t)(t + 2) * kstep; const char* b2 = last ? nB : cB + (size_t)(t + 2) * kstep;
            const char* a3 = a2 + kstep; const char* b3 = b2 + kstep;
            if (last && has_next) S.a_ready(nxt);
            if constexpr (SP2) {
            const size_t hA = full ? hstepA : 0, hA2 = last ? ((has_next && !nxt.half) ? hstepA : 0) : hA;
            PG8_LDB(B0, 0, 0); PG8_LDB(B1, 0, 1); PG8_SCHED; PG8_LDA(At, 0, 0); PG8_STAGE(PG8_SA(1, 1), a1 + hA, voffA);
            PG8_WAIT_V(8); PG8_WAIT_L(0); PG8_BAR; PG8_MMA(0, 0, At, B0); PG8_MMA(0, 1, At, B1); PG8_BAR; PG8_SCHED;
            if (full) PG8_LDA(At, 0, 1); PG8_STAGE(PG8_SB(0, 0), b2, voffB); PG8_STAGE(PG8_SB(0, 1), b2 + hstepB, voffB); PG8_STAGE(PG8_SA(0, 0), a2, voffA);
            PG8_WAIT_V(8); PG8_WAIT_L(0); PG8_BAR; if (full) { PG8_MMA(1, 0, At, B0); PG8_MMA(1, 1, At, B1); } PG8_BAR; PG8_SCHED;
            PG8_LDB(B0, 1, 0); PG8_LDB(B1, 1, 1); PG8_SCHED; PG8_LDA(At, 1, 0); PG8_STAGE(PG8_SA(0, 1), a2 + hA2, voffA);
            PG8_WAIT_V(8); PG8_WAIT_L(0); PG8_BAR; PG8_MMA(0, 0, At, B0); PG8_MMA(0, 1, At, B1); PG8_BAR; PG8_SCHED;
            if (full) PG8_LDA(At, 1, 1); PG8_STAGE(PG8_SB(1, 0), b3, voffB); PG8_STAGE(PG8_SB(1, 1), b3 + hstepB, voffB); PG8_STAGE(PG8_SA(1, 0), a3, voffA);
            PG8_WAIT_V(8); PG8_WAIT_L(0); PG8_BAR; if (full) { PG8_MMA(1, 0, At, B0); PG8_MMA(1, 1, At, B1); } PG8_BAR; PG8_SCHED;
            } else {
            PG8_LDB(B0, 0, 0); PG8_SCHED; PG8_LDA(At, 0, 0); PG8_STAGE(PG8_SA(1, 1), a1 + hstepA, voffA);
            PG8_WAIT_L(8); PG8_BAR; PG8_WAIT_L(0); PG8_MMA(0, 0, At, B0); PG8_BAR; PG8_SCHED;
            PG8_LDB(B1, 0, 1); PG8_STAGE(PG8_SB(0, 0), b2, voffB);
            PG8_BAR; PG8_WAIT_L(0); PG8_MMA(0, 1, At, B1); PG8_BAR;
            PG8_LDA(At, 0, 1); PG8_STAGE(PG8_SA(0, 0), a2, voffA);
            PG8_BAR; PG8_WAIT_L(0); if (full) PG8_MMA(1, 0, At, B0); PG8_BAR; PG8_SCHED;
            PG8_STAGE(PG8_SB(0, 1), b2 + hstepB, voffB);
            PG8_WAIT_V(6); PG8_BAR; if (full) PG8_MMA(1, 1, At, B1); PG8_BAR;
            PG8_LDB(B0, 1, 0); PG8_SCHED; PG8_LDA(At, 1, 0); PG8_STAGE(PG8_SA(0, 1), a2 + hstepA, voffA);
            PG8_WAIT_L(8); PG8_BAR; PG8_WAIT_L(0); PG8_MMA(0, 0, At, B0); PG8_BAR; PG8_SCHED;
            PG8_LDB(B1, 1, 1); PG8_STAGE(PG8_SB(1, 0), b3, voffB);
            PG8_BAR; PG8_WAIT_L(0); PG8_MMA(0, 1, At, B1); PG8_BAR;
            PG8_LDA(At, 1, 1); PG8_STAGE(PG8_SA(1, 0), a3, voffA);
            PG8_BAR; PG8_WAIT_L(0); if (full) PG8_MMA(1, 0, At, B0); PG8_BAR; PG8_SCHED;
            PG8_STAGE(PG8_SB(1, 1), b3 + hstepB, voffB);
            PG8_WAIT_V(6); PG8_BAR; if (full) PG8_MMA(1, 1, At, B1); PG8_BAR;
            }
        }
        if constexpr (ALIGN_EPI) { if (wr == 0) PG8_BAR; }
        E(acc, cur, wr, wc, fr, fq); S.done(cur);
        if (!has_next) break;
#pragma unroll
        for (int a = 0; a < 2; ++a)
#pragma unroll
            for (int b = 0; b < 2; ++b)
#pragma unroll
                for (int m = 0; m < 4; ++m)
#pragma unroll
                    for (int n = 0; n < 2; ++n) acc[a][b][m][n] = (f32x4){0.f, 0.f, 0.f, 0.f};
        cur = nxt; cA = nA; cB = nB; ++ui;
        if constexpr (ALIGN_EPI) { if (wr == 1) PG8_BAR; }
    }
    PG8_WAIT_V(0);
    if constexpr (!ALIGN_EPI) { if (wr == 0) PG8_BAR; }
    PG8_BAR;
#undef PG8_SA
#undef PG8_SB
#undef PG8_STAGE
#undef PG8_LDA
#undef PG8_LDB
#undef PG8_MMA
#undef PG8_WAIT_V
#undef PG8_WAIT_L
#undef PG8_BAR
#undef PG8_SCHED
}
}

constexpr int NWAVES = 8;
constexpr int NPHASES = 12;
constexpr int D = 4096, TP = 8192, SEQ = 2048, NS = 128, MT = 8320, MP = 8448, NCOND = 132, NMOD = 24576;
constexpr int DIN = 10256, ZW = 10240, DPOOL = 1024, DKT = 1536, DVT = 3072, DKH = 384, DVH = 768, DFF = 11008;
constexpr int ZC_Q = 1024, ZC_K = 2560, ZC_V = 4096, ZC_G = 7168;
constexpr float EPS = 1e-6f;
constexpr float QSCALE = 0.05103103630798288f;
constexpr size_t OFF_POOLP = (size_t)MT * D, OFF_GLAP = OFF_POOLP + 61440, OFF_POOLS = OFF_GLAP + 4718592, OFF_GLAS = OFF_POOLS + 1966080;

constexpr size_t al256(size_t x) { return (x + 255) & ~(size_t)255; }
constexpr size_t WS_CTL = 0, CTL_REGION = 1u << 20, CTL_ZERO_BYTES = 40960;
constexpr size_t WS_MOD = CTL_REGION;
constexpr size_t WS_SC = WS_MOD + al256((size_t)NCOND * NMOD * 4);
constexpr size_t WS_WIN = WS_SC + al256((size_t)144 * D * 2);
constexpr size_t WS_WA = WS_WIN + al256((size_t)ZW * D * 2);
constexpr size_t WS_WOUT = WS_WA + al256((size_t)16 * D * 2);
constexpr size_t WS_W13 = WS_WOUT + al256((size_t)D * D * 2);
constexpr size_t WS_WFF2 = WS_W13 + al256((size_t)2 * DFF * D * 2);
constexpr size_t WS_WP = WS_WFF2 + al256((size_t)D * DFF * 2);
constexpr size_t WS_H = WS_WP + al256((size_t)1024 * 256 * 2);
constexpr size_t WS_Z = WS_H + al256((size_t)MP * D * 2);
constexpr size_t WS_QT = WS_Z + al256((size_t)MP * ZW * 2);
constexpr size_t WS_KT = WS_QT + al256((size_t)TP * DKT * 2);
constexpr size_t WS_EBL = WS_KT + al256((size_t)TP * DKT * 2);
constexpr size_t WS_LAS = WS_EBL + al256((size_t)256 * DKT * 4);
constexpr size_t WS_DP = WS_LAS + al256((size_t)128 * DKT * 4);
constexpr size_t WS_OB = WS_DP + al256((size_t)MP * DPOOL * 2);
constexpr size_t WS_MIX = WS_OB + al256((size_t)MT * DVT * 4);
constexpr size_t WS_X1 = WS_MIX + al256((size_t)MP * D * 2);
constexpr size_t WS_ACT = WS_X1 + al256((size_t)MT * D * 4);
constexpr size_t WS_ZS = WS_ACT + al256((size_t)MP * DFF * 2);
constexpr size_t WS_XS = WS_ZS + al256((size_t)4 * NS * ZW * 4);
constexpr int OV_KS = 8, OV_N = 22, OV_SPLIT = 43, OV_PA = 32, OV_PB = 64, OV_COLS = OV_N * 128;
constexpr size_t WS_SS = WS_XS + al256((size_t)16 * NS * D * 4);
constexpr size_t WS_END = WS_SS + al256((size_t)OV_KS * 2 * NS * OV_COLS * 4);
constexpr int CW_BAR = 4096, CW_Q = 8192;

constexpr int SCRATCH_BYTES = 151552;
constexpr int MISC_OFF = SCRATCH_BYTES;
constexpr int LDS_BYTES = SCRATCH_BYTES + 512;

#define GAS __attribute__((address_space(1)))
#define LAS __attribute__((address_space(3)))
typedef unsigned short bf16;
typedef unsigned v4u __attribute__((ext_vector_type(4)));
typedef unsigned v2u __attribute__((ext_vector_type(2)));
typedef float f32x4 __attribute__((ext_vector_type(4)));
typedef short bf16x8 __attribute__((ext_vector_type(8)));
#define LDS_WAIT() asm volatile("s_waitcnt lgkmcnt(0)" ::: "memory")
__device__ __forceinline__ unsigned f2bf(float f) { unsigned u = __builtin_bit_cast(unsigned, f); return (u + 0x7fffu + ((u >> 16) & 1u)) >> 16; }
__device__ __forceinline__ unsigned pk2(float lo, float hi) { return f2bf(lo) | (f2bf(hi) << 16); }
__device__ __forceinline__ float bflo(unsigned w) { return __builtin_bit_cast(float, w << 16); }
__device__ __forceinline__ float bfhi(unsigned w) { return __builtin_bit_cast(float, w & 0xffff0000u); }
__device__ __forceinline__ float bf2f(bf16 b) { return __builtin_bit_cast(float, ((unsigned)b) << 16); }
__device__ __forceinline__ float silu_acc(float x) { return x / (1.0f + __expf(-x)); }
__device__ __forceinline__ float wave_sum(float v) {
#pragma unroll
    for (int o = 1; o < 64; o <<= 1) v += __shfl_xor(v, o);
    return v;
}

__device__ __forceinline__ int lane_fresh() { int l; asm volatile("v_mbcnt_lo_u32_b32 %0, -1, 0\n\tv_mbcnt_hi_u32_b32 %0, -1, %0" : "=v"(l)); return l; }
#define XB_TMO      128
#define XB_XCNT(j)  (256  + 64 * (j))
#define XB_XSUB(j)  (1280 + 64 * (j))
#define XB_XGEN(j)  (2304 + 64 * (j))
#define XB_TOP      3328
#define XB_TOPGEN   3392
#define XCD_BAR_WORDS 3456
#define XB_SPIN_CAP (1u << 18)

__device__ __forceinline__ unsigned xb_ld(unsigned* p)              { return __hip_atomic_load(p, __ATOMIC_RELAXED, __HIP_MEMORY_SCOPE_AGENT); }
__device__ __forceinline__ unsigned xb_add(unsigned* p, unsigned v) { return __hip_atomic_fetch_add(p, v, __ATOMIC_RELAXED, __HIP_MEMORY_SCOPE_AGENT); }
__device__ __forceinline__ unsigned xb_xcc_id() { return (unsigned)__builtin_amdgcn_s_getreg((3 << 11) | 20) & 0xFu; }
#define XB_SPIN(cond, bar) do { unsigned _sp = 0; while (cond) { __builtin_amdgcn_s_sleep(1); \
    if ((++_sp & 255u) == 0u) { if (xb_ld(&(bar)[XB_TMO])) break; if (_sp > XB_SPIN_CAP) { atomicAdd(&(bar)[XB_TMO], 1u); break; } } } } while (0)

struct XcdBarrier {
    unsigned* bar; unsigned x;
    volatile LAS unsigned* st;
};
__device__ __forceinline__ XcdBarrier xcd_barrier_post(unsigned* bar, volatile LAS unsigned* st) {
    XcdBarrier b; b.bar = bar; b.x = xb_xcc_id(); b.st = st;
    if (threadIdx.x == 0) (void)xb_add(&bar[XB_XCNT(b.x)], 1u);
    return b;
}
__device__ __forceinline__ void xcd_barrier_complete(unsigned* bar, unsigned x, unsigned& nloc, unsigned& nx) {
    const unsigned G = gridDim.x * gridDim.y * gridDim.z;
    unsigned sum, cnt, mine, sp = 0u;
    for (;;) {
        sum = 0u; cnt = 0u; mine = 0u;
#pragma unroll
        for (unsigned j = 0; j < 16; ++j) { const unsigned c = xb_ld(&bar[XB_XCNT(j)]); sum += c; cnt += (c > 0u) ? 1u : 0u; mine = (j == x) ? c : mine; }
        if (sum == G) break;
        __builtin_amdgcn_s_sleep(1);
        if ((++sp & 255u) == 0u) { if (xb_ld(&bar[XB_TMO])) break; if (sp > XB_SPIN_CAP) { atomicAdd(&bar[XB_TMO], 1u); break; } }
    }
    nloc = mine > 0u ? mine : 1u; nx = cnt > 0u ? cnt : 1u;
}
__device__ __forceinline__ void xcd_barrier(const XcdBarrier& b) {
    asm volatile("s_waitcnt vmcnt(0)" ::: "memory");
    __syncthreads();
    if (threadIdx.x == 0) {
        unsigned* bar = b.bar;
        __builtin_amdgcn_s_waitcnt(0);
        unsigned nloc = b.st[0], nx = b.st[1];
        if (nloc == 0u) { xcd_barrier_complete(bar, b.x, nloc, nx); b.st[0] = nloc; b.st[1] = nx; }
        const unsigned old = xb_add(&bar[XB_XSUB(b.x)], 1u);
        const unsigned gen = old / nloc;
        if (old + 1u == (gen + 1u) * nloc) {
            __builtin_amdgcn_fence(__ATOMIC_RELEASE, "agent");
            asm volatile("s_waitcnt vmcnt(0)" ::: "memory");
            const unsigned og = xb_add(&bar[XB_TOP], 1u);
            const unsigned tg = og / nx;
            if (og + 1u == (tg + 1u) * nx) xb_add(&bar[XB_TOPGEN], 1u);
            else XB_SPIN(xb_ld(&bar[XB_TOPGEN]) == tg, bar);
            __builtin_amdgcn_fence(__ATOMIC_ACQUIRE, "agent");
            xb_add(&bar[XB_XGEN(b.x)], 1u);
            asm volatile("s_waitcnt vmcnt(0)" ::: "memory");
        } else {
            XB_SPIN(xb_ld(&bar[XB_XGEN(b.x)]) == gen, bar);
            __builtin_amdgcn_fence(__ATOMIC_ACQUIRE, "agent");
            asm volatile("s_waitcnt vmcnt(0)" ::: "memory");
        }
    }
    __syncthreads();
}

struct Ctx {
    const float *x_prompt, *x_sample, *state_pool, *state_gla, *c_prompt, *c_sample, *w_ada, *b_ada, *g_norm1, *w_in, *w_pool, *pool_scale, *w_a2, *b_a, *g_gla_out,
                *w_out, *g_norm2, *w_ff1, *w_ff3, *w_ff2, *g_final;
    float* out;
    float* MOD; bf16* SC; bf16 *WinT, *WaT, *WoutT, *W13T, *Wff2T, *WpT; bf16 *H, *Z, *QT, *KT; float *EBL, *LAS_; bf16* DP; bf16* OB; bf16* MIX; float* X1; bf16 *X1B, *OPB; bf16* ACT; float *ZS, *XS, *SS;
    LAS unsigned char* lds; int wave, G, gw, NGW;
};

__device__ __forceinline__ void tr_item(const float* W, int ldw, bf16* WT, int ldt, int k0, int n0, int drow0, LAS float* scr, int lane) {
    const int c4 = lane & 15, r4 = lane >> 4;
    const float* wp = W + (size_t)(k0 + r4) * ldw + n0 + 4 * c4;
#pragma unroll
    for (int hh = 0; hh < 2; ++hh) { f32x4 v[8];
#pragma unroll
        for (int i = 0; i < 8; ++i) { v[i] = *(const f32x4*)wp; wp += (size_t)4 * ldw; }
#pragma unroll
        for (int i = 0; i < 8; ++i) { LAS float* s = scr + (4 * (8 * hh + i) + r4) * 65 + 4 * c4; s[0] = v[i].x; s[1] = v[i].y; s[2] = v[i].z; s[3] = v[i].w; } }
    LDS_WAIT(); asm volatile("" ::: "memory");
    const int c = lane & 7;
#pragma unroll
    for (int j = 0; j < 8; ++j) { const int n = (lane >> 3) + 8 * j; const LAS float* s = scr + (8 * c) * 65 + n;
        v4u o; o.x = pk2(s[0 * 65], s[1 * 65]); o.y = pk2(s[2 * 65], s[3 * 65]); o.z = pk2(s[4 * 65], s[5 * 65]); o.w = pk2(s[6 * 65], s[7 * 65]);
        *(v4u*)(WT + (size_t)(drow0 + n) * ldt + k0 + 8 * c) = o; }
    LDS_WAIT(); asm volatile("" ::: "memory");
}
constexpr int I_IN = 64 * 160, I_OUT = 64 * 64, I_F1 = 64 * 172, I_F2 = 172 * 64, I_P = 64;
constexpr int N_TR_ITEMS = I_IN + I_OUT + 2 * I_F1 + I_F2 + I_P;
struct TrItem { const GAS float* W; GAS bf16* WT; int ldw, ldt, k0, n0, drow0; };
__device__ __forceinline__ TrItem tr_params(const Ctx& C, int it) {
    constexpr int B0 = I_IN, B1 = B0 + I_OUT, B2 = B1 + I_F1, B3 = B2 + I_F1, B4 = B3 + I_F2;
    const bool m0 = it < B0, m1 = !m0 && it < B1, m2 = it >= B1 && it < B2, m3 = it >= B2 && it < B3, m4 = it >= B3 && it < B4, m5 = it >= B4;
    int r = it - (m1 ? B0 : 0) - (m2 ? B1 : 0) - (m3 ? B2 : 0) - (m4 ? B3 : 0) - (m5 ? B4 : 0);
    const int g = m5 ? (r >> 4) : 0; r = m5 ? (r & 15) : r;
    const int nbd = (m0 ? 160 : 0) + ((m1 || m4) ? 64 : 0) + ((m2 || m3) ? 172 : 0) + (m5 ? 4 : 0);
    const int kb = r / nbd, nb = r - kb * nbd;
    typedef unsigned long long u64;
    const u64 wsel = ((u64)C.w_in & (u64)-(long long)m0) | ((u64)C.w_out & (u64)-(long long)m1) | ((u64)C.w_ff1 & (u64)-(long long)m2) | ((u64)C.w_ff3 & (u64)-(long long)m3) | ((u64)C.w_ff2 & (u64)-(long long)m4) | ((u64)C.w_pool & (u64)-(long long)m5);
    const u64 tsel = ((u64)C.WinT & (u64)-(long long)m0) | ((u64)C.WoutT & (u64)-(long long)m1) | ((u64)C.W13T & (u64)-(long long)(m2 || m3)) | ((u64)C.Wff2T & (u64)-(long long)m4) | ((u64)C.WpT & (u64)-(long long)m5);
    TrItem T;
    T.W = (const GAS float*)wsel + (size_t)g * 65536;
    T.WT = (GAS bf16*)tsel + (size_t)g * 65536;
    T.ldw = (m0 ? DIN : 0) + ((m1 || m4) ? D : 0) + ((m2 || m3) ? DFF : 0) + (m5 ? 256 : 0);
    T.ldt = m4 ? DFF : (m5 ? 256 : D);
    T.k0 = 64 * kb; T.n0 = 64 * nb;
    T.drow0 = (m2 || m3) ? ((T.n0 >> 7) * 256 + (T.n0 & 127) + (m3 ? 128 : 0)) : T.n0;
    return T;
}
__device__ __forceinline__ void tr_dispatch(const Ctx& C, int it, LAS float* scr, int lane) {
    const TrItem T = tr_params(C, it);
    tr_item((const float*)T.W, T.ldw, (bf16*)T.WT, T.ldt, T.k0, T.n0, T.drow0, scr, lane);
}
__device__ __forceinline__ void p0_small(const Ctx& C) {
    const int lane = lane_fresh();
    for (int i = C.gw * 64 + lane; i < 16 * D; i += C.NGW * 64) { const int r = i >> 12, k = i & 4095; C.WaT[i] = (bf16)f2bf(C.w_in[(size_t)k * DIN + ZW + r]); }
    for (int i = C.gw * 64 + lane; i < 144 * D; i += C.NGW * 64) { const int m = i >> 12, k = i & 4095; float v = 0.f;
        if (m < 4) v = silu_acc(C.c_prompt[m * D + k]); else if (m < NCOND) v = silu_acc(C.c_sample[(m - 4) * D + k]);
        C.SC[i] = (bf16)f2bf(v); }
}

struct __attribute__((packed, aligned(4))) F3 { float x, y, z; };
template <bool TR>
__device__ __forceinline__ void p1_kstep(const Ctx& C, f32x4 (&acc)[9][3], const __amdgpu_buffer_rsrc_t rB, const __amdgpu_buffer_rsrc_t rA, int& sB, int& sA, int tr_it, LAS float* scr) {
    const int lane = lane_fresh();
    const unsigned boff = (unsigned)((8 * (lane >> 4)) * NMOD + 3 * (lane & 15)) * 4u, aoff = (unsigned)((lane & 15) * D + 8 * (lane >> 4)) * 2u;
    typedef decltype(__builtin_amdgcn_raw_buffer_load_b96(rB, 0u, 0, 0)) ld3_t; typedef decltype(__builtin_amdgcn_raw_buffer_load_b128(rA, 0u, 0, 0)) ld4_t;
#define P1_F(u_) __uint_as_float((unsigned)(u_))
    const int c4 = lane & 15, r4 = lane >> 4;
    TrItem T; const GAS float* wp = nullptr; f32x4 tv[8];
    if constexpr (TR) { T = tr_params(C, tr_it); wp = T.W + (size_t)(T.k0 + r4) * T.ldw + T.n0 + 4 * c4;
#pragma unroll
        for (int i = 0; i < 8; ++i) { tv[i] = *(const GAS f32x4*)wp; wp += (size_t)4 * T.ldw; } }
    __builtin_amdgcn_sched_barrier(0);
    ld3_t RW[8]; ld4_t AF[9];
#pragma unroll
    for (int j = 0; j < 8; ++j) RW[j] = __builtin_amdgcn_raw_buffer_load_b96(rB, boff, sB + j * NMOD * 4, 0);
    sB += 32 * NMOD * 4;
    __builtin_amdgcn_sched_barrier(0);
    if constexpr (!TR) {
#pragma unroll
        for (int mt = 0; mt < 9; ++mt) AF[mt] = __builtin_amdgcn_raw_buffer_load_b128(rA, aoff, sA + 16 * mt * D * 2, 0);
    }
    if constexpr (TR) {
#pragma unroll
        for (int i = 0; i < 8; ++i) { LAS float* s = scr + (4 * i + r4) * 65 + 4 * c4; s[0] = tv[i].x; s[1] = tv[i].y; s[2] = tv[i].z; s[3] = tv[i].w; }
        __builtin_amdgcn_sched_barrier(0);
#pragma unroll
        for (int i = 0; i < 8; ++i) { tv[i] = *(const GAS f32x4*)wp; wp += (size_t)4 * T.ldw; }
        __builtin_amdgcn_sched_barrier(0);
#pragma unroll
        for (int i = 0; i < 8; ++i) { LAS float* s = scr + (4 * (8 + i) + r4) * 65 + 4 * c4; s[0] = tv[i].x; s[1] = tv[i].y; s[2] = tv[i].z; s[3] = tv[i].w; }
        __builtin_amdgcn_sched_barrier(0);
#pragma unroll
        for (int mt = 0; mt < 9; ++mt) AF[mt] = __builtin_amdgcn_raw_buffer_load_b128(rA, aoff, sA + 16 * mt * D * 2, 0);
        __builtin_amdgcn_sched_barrier(0);
        LDS_WAIT(); asm volatile("" ::: "memory");
        const int c = lane & 7;
#pragma unroll
        for (int j = 0; j < 8; ++j) { const int n = (lane >> 3) + 8 * j; const LAS float* s = scr + (8 * c) * 65 + n;
            v4u o; o.x = pg8::cvt_pk_bf16(s[0 * 65], s[1 * 65]); o.y = pg8::cvt_pk_bf16(s[2 * 65], s[3 * 65]); o.z = pg8::cvt_pk_bf16(s[4 * 65], s[5 * 65]); o.w = pg8::cvt_pk_bf16(s[6 * 65], s[7 * 65]);
            *(GAS v4u*)(T.WT + (size_t)(T.drow0 + n) * T.ldt + T.k0 + 8 * c) = o; }
        LDS_WAIT(); asm volatile("" ::: "memory");
    }
    sA += 64;
    v4u b0, b1, b2;
    b0.x = pg8::cvt_pk_bf16(P1_F(RW[0][0]), P1_F(RW[1][0])); b0.y = pg8::cvt_pk_bf16(P1_F(RW[2][0]), P1_F(RW[3][0])); b0.z = pg8::cvt_pk_bf16(P1_F(RW[4][0]), P1_F(RW[5][0])); b0.w = pg8::cvt_pk_bf16(P1_F(RW[6][0]), P1_F(RW[7][0]));
    b1.x = pg8::cvt_pk_bf16(P1_F(RW[0][1]), P1_F(RW[1][1])); b1.y = pg8::cvt_pk_bf16(P1_F(RW[2][1]), P1_F(RW[3][1])); b1.z = pg8::cvt_pk_bf16(P1_F(RW[4][1]), P1_F(RW[5][1])); b1.w = pg8::cvt_pk_bf16(P1_F(RW[6][1]), P1_F(RW[7][1]));
    b2.x = pg8::cvt_pk_bf16(P1_F(RW[0][2]), P1_F(RW[1][2])); b2.y = pg8::cvt_pk_bf16(P1_F(RW[2][2]), P1_F(RW[3][2])); b2.z = pg8::cvt_pk_bf16(P1_F(RW[4][2]), P1_F(RW[5][2])); b2.w = pg8::cvt_pk_bf16(P1_F(RW[6][2]), P1_F(RW[7][2]));
    const bf16x8 B0 = __builtin_bit_cast(bf16x8, b0), B1 = __builtin_bit_cast(bf16x8, b1), B2 = __builtin_bit_cast(bf16x8, b2);
#pragma unroll
    for (int mt = 0; mt < 9; ++mt) { const bf16x8 a_ = __builtin_bit_cast(bf16x8, AF[mt]);
        acc[mt][0] = __builtin_amdgcn_mfma_f32_16x16x32_bf16(a_, B0, acc[mt][0], 0, 0, 0);
        acc[mt][1] = __builtin_amdgcn_mfma_f32_16x16x32_bf16(a_, B1, acc[mt][1], 0, 0, 0);
        acc[mt][2] = __builtin_amdgcn_mfma_f32_16x16x32_bf16(a_, B2, acc[mt][2], 0, 0, 0); }
#undef P1_F
}
__device__ __forceinline__ void p1_adaln(const Ctx& C) {
    const int w = C.wave, sub = w & 1, kq = w >> 1;
    LAS f32x4* slab = (LAS f32x4*)C.lds;
    LAS float* scr = (LAS float*)(C.lds + w * 16640);
    int tr_it = C.gw;
    const __amdgpu_buffer_rsrc_t rB = __builtin_amdgcn_make_buffer_rsrc((void*)C.w_ada, 0, (int)((size_t)D * NMOD * 4), 0x00020000);
    const __amdgpu_buffer_rsrc_t rA = __builtin_amdgcn_make_buffer_rsrc((void*)C.SC, 0, 144 * D * 2, 0x00020000);
    for (int cg = blockIdx.x; cg < 256; cg += C.G) {
        const int n0 = 96 * cg + 48 * sub, kbase = 1024 * kq;
        f32x4 acc[9][3];
#pragma unroll
        for (int mt = 0; mt < 9; ++mt)
#pragma unroll
            for (int i = 0; i < 3; ++i) acc[mt][i] = (f32x4){0.f, 0.f, 0.f, 0.f};
        int sB = (kbase * NMOD + n0) * 4, sA = kbase * 2;
        int ks = 0;
#pragma unroll 1
        for (; ks < 32 && tr_it < N_TR_ITEMS; ++ks) { p1_kstep<true>(C, acc, rB, rA, sB, sA, tr_it, scr); tr_it += C.NGW; }
#pragma unroll 1
        for (; ks < 32; ++ks) p1_kstep<false>(C, acc, rB, rA, sB, sA, 0, scr);
        __syncthreads();
        { const int lane = lane_fresh(), c = lane & 15, g = lane >> 4;
        if (w >= 4) {
#pragma unroll
            for (int q = 0; q < 27; ++q) slab[(w - 4) * 27 * 64 + q * 64 + lane] = acc[q / 3][q % 3];
        }
        __syncthreads();
        if (w < 4) {
#pragma unroll
            for (int q = 0; q < 27; ++q) { acc[q / 3][q % 3] += slab[w * 27 * 64 + q * 64 + lane]; if ((q % 3) == 2) asm volatile("" ::: "memory"); }
            if (w >= 2) {
#pragma unroll
                for (int q = 0; q < 27; ++q) slab[w * 27 * 64 + q * 64 + lane] = acc[q / 3][q % 3];
            }
        }
        __syncthreads();
        if (w < 2) {
#pragma unroll
            for (int q = 0; q < 27; ++q) { acc[q / 3][q % 3] += slab[(w + 2) * 27 * 64 + q * 64 + lane]; if ((q % 3) == 2) asm volatile("" ::: "memory"); }
            const float bb0 = C.b_ada[n0 + 3 * c], bb1 = C.b_ada[n0 + 3 * c + 1], bb2 = C.b_ada[n0 + 3 * c + 2];
            int g2 = g; asm volatile("" : "+v"(g2));
            GAS float* o = (GAS float*)C.MOD + (size_t)(4 * g2) * NMOD + n0 + 3 * c;
#pragma unroll
            for (int mt = 0; mt < 9; ++mt) {
#pragma unroll
                for (int r = 0; r < 4; ++r) { const int m = 16 * mt + 4 * g2 + r;
                    if (m < NCOND) { o[0] = acc[mt][0][r] + bb0; o[1] = acc[mt][1][r] + bb1; o[2] = acc[mt][2][r] + bb2; }
                    o += NMOD; asm volatile("" : "+v"(o)); }
                o += 12 * NMOD; }
        }
        }
        __syncthreads();
    }
    for (; tr_it < N_TR_ITEMS; tr_it += C.NGW) tr_dispatch(C, tr_it, scr, lane_fresh());
}

template <int NSL>
__device__ __forceinline__ void sample_row_from_slabs(const float* base, const float* gate, const float* slabs, int n, f32x4 (&v)[2], float& ssq, LAS float* lds_red, int t, int w) {
#pragma unroll
    for (int j = 0; j < 2; ++j) { const int c = 4 * t + 2048 * j;
        f32x4 a = *(const f32x4*)(slabs + ((size_t)0 * NS + n) * D + c);
#pragma unroll
        for (int k = 1; k < NSL; ++k) a += *(const f32x4*)(slabs + ((size_t)k * NS + n) * D + c);
        v[j] = *(const f32x4*)(base + c) + *(const f32x4*)(gate + c) * a; }
    float s = (v[0].x * v[0].x + v[0].y * v[0].y) + (v[0].z * v[0].z + v[0].w * v[0].w) + (v[1].x * v[1].x + v[1].y * v[1].y) + (v[1].z * v[1].z + v[1].w * v[1].w);
    s = wave_sum(s);
    __syncthreads();
    if ((t & 63) == 0) lds_red[w] = s;
    __syncthreads();
    ssq = 0.f;
#pragma unroll
    for (int ww = 0; ww < 8; ++ww) ssq += lds_red[ww];
}

template <bool X16>
__device__ __forceinline__ void norm_rows(const Ctx& C, const float* xa, const bf16* xa16, const float* xb, const float* gain, int sh_off, int sc_off, bf16* Hout, const float* slabs, int gate_off, float* x1s) {
    const int lane = lane_fresh();
    for (int row = C.gw; row < MP; row += C.NGW) {
        v2u* o = (v2u*)(Hout + (size_t)row * D) + lane;
        if (row >= MT) {
#pragma unroll
            for (int j = 0; j < 16; ++j) o[64 * j] = (v2u){0u, 0u};
            continue;
        }
        if (slabs != nullptr && row >= TP) continue;
        if (X16 && row < TP) {
            const v4u* xv = (const v4u*)(xa16 + (size_t)row * D) + lane;
            v4u w[8]; float s = 0.f;
#pragma unroll
            for (int j = 0; j < 8; ++j) w[j] = xv[64 * j];
#pragma unroll
            for (int j = 0; j < 8; ++j) { const float a0 = bflo(w[j].x), a1 = bfhi(w[j].x), a2 = bflo(w[j].y), a3 = bfhi(w[j].y), a4 = bflo(w[j].z), a5 = bfhi(w[j].z), a6 = bflo(w[j].w), a7 = bfhi(w[j].w);
                s += ((a0 * a0 + a1 * a1) + (a2 * a2 + a3 * a3)) + ((a4 * a4 + a5 * a5) + (a6 * a6 + a7 * a7)); }
            const float rstd = 1.0f / sqrtf(wave_sum(s) * (1.0f / D) + EPS);
            const float* md = C.MOD + (size_t)(row >> 11) * NMOD;
            v4u* ob = (v4u*)(Hout + (size_t)row * D) + lane;
#pragma unroll
            for (int j = 0; j < 8; ++j) { const int c = 8 * (64 * j + lane);
                const f32x4 g0 = *(const f32x4*)(gain + c), g1 = *(const f32x4*)(gain + c + 4), sh0 = *(const f32x4*)(md + sh_off + c), sh1 = *(const f32x4*)(md + sh_off + c + 4);
                const f32x4 sc0 = *(const f32x4*)(md + sc_off + c), sc1 = *(const f32x4*)(md + sc_off + c + 4);
                const f32x4 x0 = (f32x4){bflo(w[j].x), bfhi(w[j].x), bflo(w[j].y), bfhi(w[j].y)}, x1 = (f32x4){bflo(w[j].z), bfhi(w[j].z), bflo(w[j].w), bfhi(w[j].w)};
                const f32x4 h0 = x0 * rstd * g0 * (sc0 + 1.0f) + sh0, h1 = x1 * rstd * g1 * (sc1 + 1.0f) + sh1;
                ob[64 * j] = (v4u){pk2(h0.x, h0.y), pk2(h0.z, h0.w), pk2(h1.x, h1.y), pk2(h1.z, h1.w)}; }
            continue;
        }
        const float* xr = row < TP ? xa + (size_t)row * D : xb + (size_t)(row - TP) * D;
        const int ci = row < TP ? (row >> 11) : (4 + row - TP);
        const f32x4* xv = (const f32x4*)xr + lane;
        f32x4 v[16]; float s = 0.f;
#pragma unroll
        for (int j = 0; j < 16; ++j) { v[j] = xv[64 * j]; s += (v[j].x * v[j].x + v[j].y * v[j].y) + (v[j].z * v[j].z + v[j].w * v[j].w); }
        const float rstd = 1.0f / sqrtf(wave_sum(s) * (1.0f / D) + EPS);
        const f32x4* gv = (const f32x4*)gain + lane;
        const f32x4* shv = (const f32x4*)(C.MOD + (size_t)ci * NMOD + sh_off) + lane;
        const f32x4* scv = (const f32x4*)(C.MOD + (size_t)ci * NMOD + sc_off) + lane;
#pragma unroll
        for (int j = 0; j < 16; ++j) { const f32x4 gg = gv[64 * j], sh = shv[64 * j], sc = scv[64 * j];
            const f32x4 h = v[j] * rstd * gg * (sc + 1.0f) + sh;
            o[64 * j] = (v2u){pk2(h.x, h.y), pk2(h.z, h.w)}; }
    }
    if (slabs != nullptr) {
        const int t = threadIdx.x, w = C.wave;
        for (int n = blockIdx.x; n < NS; n += C.G) {
            const int row = TP + n; const float* md = C.MOD + (size_t)(4 + n) * NMOD;
            f32x4 v[2]; float ssq;
            sample_row_from_slabs<8>(xb + (size_t)n * D, md + gate_off, slabs, n, v, ssq, (LAS float*)C.lds, t, w);
            const float rstd = 1.0f / sqrtf(ssq * (1.0f / D) + EPS);
#pragma unroll
            for (int j = 0; j < 2; ++j) { const int c = 4 * t + 2048 * j;
                *(f32x4*)(x1s + (size_t)row * D + c) = v[j];
                const f32x4 gg = *(const f32x4*)(gain + c), sh = *(const f32x4*)(md + sh_off + c), sc = *(const f32x4*)(md + sc_off + c);
                const f32x4 h = v[j] * rstd * gg * (sc + 1.0f) + sh;
                *(v2u*)(Hout + (size_t)row * D + c) = (v2u){pk2(h.x, h.y), pk2(h.z, h.w)}; }
        }
    }
}

__device__ __forceinline__ float log_sigmoid_f(float x) { return fminf(x, 0.f) - __logf(1.0f + __expf(-fabsf(x))); }
template <int W>
__device__ __forceinline__ void pool_rows32(const Ctx& C, int row0, int t0, int t) {
    const char* zb = (const char*)C.Z + (size_t)row0 * ZW * 2;
    char* db = (char*)C.DP + (size_t)row0 * DPOOL * 2;
    const unsigned vo = 4u * (unsigned)t;
    unsigned u[W - 1 + 32];
#pragma unroll
    for (int k = 0; k < W - 1; ++k) { const int r = t0 - (W - 1) + k; u[k] = (r >= 0) ? *(const unsigned*)(zb - (ptrdiff_t)(W - 1 - k) * ZW * 2 + vo) : 0u; }
#pragma unroll
    for (int i = 0; i < 32; ++i) u[W - 1 + i] = *(const unsigned*)(zb + (size_t)i * ZW * 2 + vo);
    float s0 = 0.f, s1 = 0.f;
#pragma unroll
    for (int k = 0; k < W - 1; ++k) { s0 += bflo(u[k]); s1 += bfhi(u[k]); }
    const bool tail = (t0 + 32 == SEQ);
#pragma unroll
    for (int i = 0; i < 32; ++i) { const unsigned cur = u[W - 1 + i]; const float u0 = bflo(cur), u1 = bfhi(cur);
        s0 += u0; s1 += u1;
        if (i > 0) { s0 -= bflo(u[i - 1]); s1 -= bfhi(u[i - 1]); }
        const int pos = t0 + i; const float inv = 1.0f / (float)(pos + 1 < W ? pos + 1 : W);
        *(unsigned*)(db + (size_t)i * DPOOL * 2 + vo) = pk2(s0 * inv - u0, s1 * inv - u1);
        if (i >= 17 && tail) { float* o = (float*)((char*)(C.out + OFF_POOLP + ((size_t)(row0 / SEQ) * 15 + (i - 17)) * DPOOL) + 2u * vo); o[0] = u0; o[1] = u1; } }
}
__device__ __forceinline__ void p4_prep(const Ctx& C) {
    const int t = threadIdx.x, lane = lane_fresh(), w = C.wave;
    LAS float* part = (LAS float*)C.lds;
    LAS float* alr = (LAS float*)(C.lds + 16384);
    LAS float* sred = (LAS float*)(C.lds + 16384 + 2048);
    LAS float* salr = sred + 128;
    for (int i = blockIdx.x * 512 + t; i < NS * ZW / 4; i += C.G * 512) { const int n = i / (ZW / 4), c4 = i % (ZW / 4);
        f32x4 a = *(const f32x4*)(C.ZS + ((size_t)0 * NS + n) * ZW + 4 * c4);
#pragma unroll
        for (int k = 1; k < 4; ++k) a += *(const f32x4*)(C.ZS + ((size_t)k * NS + n) * ZW + 4 * c4);
        *(v2u*)(C.Z + (size_t)(TP + n) * ZW + 4 * c4) = (v2u){pk2(a.x, a.y), pk2(a.z, a.w)}; }
    for (int ch = blockIdx.x; ch < TP / 32; ch += C.G) {
        const int row0 = 32 * ch;
        {
            const int r = lane & 15, g = lane >> 4;
            f32x4 pa[2] = {(f32x4){0.f, 0.f, 0.f, 0.f}, (f32x4){0.f, 0.f, 0.f, 0.f}};
#pragma unroll 8
            for (int ks = 0; ks < 16; ++ks) { const int k = 512 * w + 32 * ks + 8 * g;
                const bf16x8 bw = *(const bf16x8*)(C.WaT + (size_t)r * D + k);
#pragma unroll
                for (int mt = 0; mt < 2; ++mt) { const bf16x8 a = *(const bf16x8*)(C.H + (size_t)(row0 + 16 * mt + r) * D + k);
                    pa[mt] = __builtin_amdgcn_mfma_f32_16x16x32_bf16(a, bw, pa[mt], 0, 0, 0); } }
#pragma unroll
            for (int mt = 0; mt < 2; ++mt)
#pragma unroll
                for (int q = 0; q < 4; ++q) part[w * 512 + (16 * mt + 4 * g + q) * 16 + r] = pa[mt][q];
        }
        __syncthreads();
        { float sm = 0.f;
#pragma unroll
            for (int ww = 0; ww < 8; ++ww) sm += part[ww * 512 + t];
            alr[t] = sm; }
        __syncthreads();
#pragma unroll 1
        for (int cc = 0; cc < 3; ++cc) { const int c = t + 512 * cc; const unsigned vq = 2u * (unsigned)(ZC_Q + c), vk = 2u * (unsigned)(ZC_K + c), vc = 2u * (unsigned)c;
            float w2[16]; const float ba = C.b_a[c];
#pragma unroll
            for (int r = 0; r < 16; ++r) w2[r] = C.w_a2[r * DKT + c];
            float bc = 0.f;
#pragma unroll 1
            for (int hh = 0; hh < 2; ++hh) {
                const char* zb = (const char*)C.Z + (size_t)(row0 + 16 * hh) * ZW * 2;
                char* qb = (char*)C.QT + (size_t)(row0 + 16 * hh) * DKT * 2; char* kb = (char*)C.KT + (size_t)(row0 + 16 * hh) * DKT * 2;
                bf16 qv[16], kv[16];
#pragma unroll
                for (int i = 0; i < 16; ++i) { qv[i] = *(const bf16*)(zb + (size_t)i * ZW * 2 + vq); kv[i] = *(const bf16*)(zb + (size_t)i * ZW * 2 + vk); }
#pragma unroll
                for (int i = 0; i < 16; ++i) {
                    float x = ba;
#pragma unroll
                    for (int q = 0; q < 4; ++q) { const f32x4 av = *(const LAS f32x4*)(alr + (16 * hh + i) * 16 + 4 * q);
                        x = fmaf(av.x, w2[4 * q], x); x = fmaf(av.y, w2[4 * q + 1], x); x = fmaf(av.z, w2[4 * q + 2], x); x = fmaf(av.w, w2[4 * q + 3], x); }
                    bc += log_sigmoid_f(x) * (1.0f / 16.0f);
                    *(bf16*)(qb + (size_t)i * DKT * 2 + vc) = (bf16)f2bf(bf2f(qv[i]) * QSCALE * __expf(bc));
                    *(bf16*)(kb + (size_t)i * DKT * 2 + vc) = (bf16)f2bf(bf2f(kv[i]) * __expf(-bc));
                }
            }
            C.EBL[(size_t)ch * DKT + c] = __expf(bc);
        }
        { const int t0 = row0 & (SEQ - 1);
            switch (w >> 1) { case 0: pool_rows32<2>(C, row0, t0, t); break; case 1: pool_rows32<4>(C, row0, t0, t); break;
                              case 2: pool_rows32<8>(C, row0, t0, t); break; default: pool_rows32<16>(C, row0, t0, t); break; } }
        __syncthreads();
    }
    for (int n = blockIdx.x; n < NS; n += C.G) {
        const int row = TP + n;
        {
            const v4u hv = *(const v4u*)(C.H + (size_t)row * D + 8 * t);
            const float hf[8] = {bflo(hv.x), bfhi(hv.x), bflo(hv.y), bfhi(hv.y), bflo(hv.z), bfhi(hv.z), bflo(hv.w), bfhi(hv.w)};
#pragma unroll
            for (int r = 0; r < 16; ++r) { const v4u wv = *(const v4u*)(C.WaT + (size_t)r * D + 8 * t);
                float p = hf[0] * bflo(wv.x) + hf[1] * bfhi(wv.x) + hf[2] * bflo(wv.y) + hf[3] * bfhi(wv.y) + hf[4] * bflo(wv.z) + hf[5] * bfhi(wv.z) + hf[6] * bflo(wv.w) + hf[7] * bfhi(wv.w);
                p = wave_sum(p);
                if (lane == 0) sred[w * 16 + r] = p; }
        }
        __syncthreads();
        if (t < 16) { float sm = 0.f;
#pragma unroll
            for (int ww = 0; ww < 8; ++ww) sm += sred[ww * 16 + t];
            salr[t] = sm; }
        __syncthreads();
        float a[16];
#pragma unroll
        for (int q = 0; q < 4; ++q) { const f32x4 av = *(const LAS f32x4*)(salr + 4 * q); a[4 * q] = av.x; a[4 * q + 1] = av.y; a[4 * q + 2] = av.z; a[4 * q + 3] = av.w; }
#pragma unroll
        for (int cc = 0; cc < 3; ++cc) { const int c = t + 512 * cc; float x = C.b_a[c];
#pragma unroll
            for (int r = 0; r < 16; ++r) x = fmaf(a[r], C.w_a2[r * DKT + c], x);
            C.LAS_[(size_t)n * DKT + c] = log_sigmoid_f(x) * (1.0f / 16.0f); }
        __syncthreads();
    }
}

__device__ __forceinline__ void p5_sample_pool(const Ctx& C) {
    const int t = threadIdx.x, w = C.wave;
    for (int n = blockIdx.x; n < NS; n += C.G) {
        const int row = TP + n;
        {
            const int wdw = 2 << (w >> 1); const float inv = 1.0f / (float)wdw;
            const unsigned uu = ((const unsigned*)C.Z)[(size_t)row * (ZW / 2) + t]; const float u0 = bflo(uu), u1 = bfhi(uu);
            const float* sp = C.state_pool + (size_t)n * 15 * DPOOL + 2 * t;
            float* so = C.out + OFF_POOLS + (size_t)n * 15 * DPOOL + 2 * t;
            float s0 = u0, s1 = u1;
#pragma unroll
            for (int r = 0; r < 15; ++r) { const float p0 = sp[(size_t)r * DPOOL], p1 = sp[(size_t)r * DPOOL + 1];
                if (r >= 16 - wdw) { s0 += p0; s1 += p1; }
                if (r >= 1) { so[(size_t)(r - 1) * DPOOL] = p0; so[(size_t)(r - 1) * DPOOL + 1] = p1; } }
            so[(size_t)14 * DPOOL] = u0; so[(size_t)14 * DPOOL + 1] = u1;
            ((unsigned*)C.DP)[(size_t)row * (DPOOL / 2) + t] = pk2(s0 * inv - u0, s1 * inv - u1);
        }
    }
}

__device__ __forceinline__ void p5_gla_sample_q(const Ctx& C, unsigned* qctr) {
    const int t = threadIdx.x, lane = lane_fresh(), w = C.wave;
    LAS float* qs = (LAS float*)C.lds; LAS float* ks = qs + 384; LAS float* as = ks + 384;
    LAS float* opart = (LAS float*)(C.lds + 8192);
    volatile LAS unsigned* itw = (volatile LAS unsigned*)(C.lds + 8192 + 8192);
    if (t == 0) itw[0] = atomicAdd(qctr, 1u);
    __syncthreads();
    for (int par = 0;; par ^= 1) {
        const int it = (int)itw[par];
        if (it >= NS * 12) break;
        if (t == 0) itw[par ^ 1] = atomicAdd(qctr, 1u);
        const int n = it / 12, r12 = it % 12, h = r12 / 3, et = r12 % 3, row = TP + n;
        if (t < DKH) { qs[t] = bf2f(C.Z[(size_t)row * ZW + ZC_Q + h * DKH + t]) * QSCALE; ks[t] = bf2f(C.Z[(size_t)row * ZW + ZC_K + h * DKH + t]);
            as[t] = __expf(C.LAS_[(size_t)n * DKT + h * DKH + t]); }
        const v2u vv = *(const v2u*)(C.Z + (size_t)row * ZW + ZC_V + h * DVH + 256 * et + 4 * lane);
        const f32x4 v = (f32x4){bflo(vv.x), bfhi(vv.x), bflo(vv.y), bfhi(vv.y)};
        f32x4 o = (f32x4){0.f, 0.f, 0.f, 0.f};
        const float* S0 = C.state_gla + ((size_t)(n * 4 + h) * DKH + w) * DVH + 256 * et + 4 * lane;
        float* S1 = C.out + OFF_GLAS + ((size_t)(n * 4 + h) * DKH + w) * DVH + 256 * et + 4 * lane;
        f32x4 ra[16], rb[16];
#pragma unroll
        for (int i = 0; i < 16; ++i) ra[i] = __builtin_nontemporal_load((const f32x4*)(S0 + (size_t)(8 * i) * DVH));
#pragma unroll
        for (int i = 0; i < 16; ++i) rb[i] = __builtin_nontemporal_load((const f32x4*)(S0 + (size_t)(8 * (16 + i)) * DVH));
        __syncthreads();
#pragma unroll
        for (int i = 0; i < 16; ++i) { const int d = w + 8 * i; const f32x4 sn = ra[i] * as[d] + v * ks[d];
            __builtin_nontemporal_store(sn, (f32x4*)(S1 + (size_t)(8 * i) * DVH)); o += sn * qs[d]; }
#pragma unroll
        for (int i = 0; i < 16; ++i) ra[i] = __builtin_nontemporal_load((const f32x4*)(S0 + (size_t)(8 * (32 + i)) * DVH));
#pragma unroll
        for (int i = 0; i < 16; ++i) { const int d = w + 8 * (16 + i); const f32x4 sn = rb[i] * as[d] + v * ks[d];
            __builtin_nontemporal_store(sn, (f32x4*)(S1 + (size_t)(8 * (16 + i)) * DVH)); o += sn * qs[d]; }
#pragma unroll
        for (int i = 0; i < 16; ++i) { const int d = w + 8 * (32 + i); const f32x4 sn = ra[i] * as[d] + v * ks[d];
            __builtin_nontemporal_store(sn, (f32x4*)(S1 + (size_t)(8 * (32 + i)) * DVH)); o += sn * qs[d]; }
        *(LAS f32x4*)(opart + w * 256 + 4 * lane) = o;
        __syncthreads();
        if (t < 256) { float sum = 0.f;
#pragma unroll
            for (int ww = 0; ww < 8; ++ww) sum += opart[ww * 256 + t];
            C.OB[(size_t)row * DVT + h * DVH + 256 * et + t] = (bf16)f2bf(sum); }
        __syncthreads();
    }
}

constexpr int GL_QL = 0, GL_KL = 24576, GL_KT = 49152, GL_VT = 76800, GL_P = 81408, GL_OS = 83712;
__device__ __forceinline__ bf16x8 mk_frag(v2u lo, v2u hi) { v4u x; x.x = lo.x; x.y = lo.y; x.z = hi.x; x.w = hi.y; return __builtin_bit_cast(bf16x8, x); }
__device__ __forceinline__ void p5_gla_prompt(const Ctx& C) {
    const int t = threadIdx.x, lane = lane_fresh(), w = C.wave, c = lane & 15, g = lane >> 4, dg = w >> 1, eh = w & 1;
    LAS unsigned char* L = C.lds;
    for (int item = blockIdx.x; item < 192; item += C.G) {
        const int bh = 2 * (item & 7) + ((item >> 3) / 12), es = (item >> 3) % 12, h = bh & 3, b = bh >> 2;
        const bf16* qg = C.QT + (size_t)(b * SEQ) * DKT + h * DKH;
        const bf16* kg = C.KT + (size_t)(b * SEQ) * DKT + h * DKH;
        const bf16* vg = C.Z + (size_t)(b * SEQ) * ZW + ZC_V + h * DVH + 64 * es;
        const int q_row[3] = {t / 48, (t + 512) / 48, (t + 1024) / 48}, q_ch[3] = {t % 48, (t + 512) % 48, (t + 1024) % 48};
        const int k_rp = t & 15, k_ch0 = t >> 4, k_ch1 = (t >> 4) + 32;
        const int v_rp = t & 15, v_ch = t >> 4;
        f32x4 R[3][2][2];
#pragma unroll
        for (int p = 0; p < 3; ++p)
#pragma unroll
            for (int hf = 0; hf < 2; ++hf)
#pragma unroll
                for (int et = 0; et < 2; ++et) R[p][hf][et] = (f32x4){0.f, 0.f, 0.f, 0.f};
        if (t < 128) { const int i = t >> 3, q = t & 7; *(LAS unsigned*)(L + GL_P + i * 72 + 32 + 4 * q) = 0u; }
        v4u pq[3], pk[4], pv[2];
        const unsigned qo0 = (unsigned)(q_row[0] * DKT + 8 * q_ch[0]) * 2u, qo1 = (unsigned)(q_row[1] * DKT + 8 * q_ch[1]) * 2u, qo2 = (unsigned)(q_row[2] * DKT + 8 * q_ch[2]) * 2u;
        const unsigned ko0 = (unsigned)(2 * k_rp * DKT + 8 * k_ch0) * 2u, ko1 = (unsigned)(2 * k_rp * DKT + 8 * (t < 256 ? k_ch1 : k_ch0)) * 2u, vo0 = (unsigned)(2 * v_rp * ZW + 8 * (t < 128 ? v_ch : 0)) * 2u;
#define GLA_PREFETCH(s_) do { const char* qb_ = (const char*)qg + (size_t)(s_) * 32 * DKT * 2; const char* kb_ = (const char*)kg + (size_t)(s_) * 32 * DKT * 2; const char* vb_ = (const char*)vg + (size_t)(s_) * 32 * ZW * 2; \
            pq[0] = *(const v4u*)(qb_ + qo0); pq[1] = *(const v4u*)(qb_ + qo1); pq[2] = *(const v4u*)(qb_ + qo2); \
            pk[0] = *(const v4u*)(kb_ + ko0); pk[1] = *(const v4u*)(kb_ + ko0 + DKT * 2); \
            pk[2] = *(const v4u*)(kb_ + ko1); pk[3] = *(const v4u*)(kb_ + ko1 + DKT * 2); \
            pv[0] = *(const v4u*)(vb_ + vo0); pv[1] = *(const v4u*)(vb_ + vo0 + ZW * 2); } while (0)
        GLA_PREFETCH(0);
#pragma unroll 1
        for (int s = 0; s < 64; ++s) {
#pragma unroll
            for (int q = 0; q < 3; ++q) *(LAS v4u*)(L + GL_QL + q_row[q] * 768 + 16 * (q_ch[q] ^ (q_row[q] & 15))) = pq[q];
            {
                const int r0 = 2 * k_rp, r1 = 2 * k_rp + 1;
                *(LAS v4u*)(L + GL_KL + r0 * 768 + 16 * (k_ch0 ^ (r0 & 15))) = pk[0];
                *(LAS v4u*)(L + GL_KL + r1 * 768 + 16 * (k_ch0 ^ (r1 & 15))) = pk[1];
                const unsigned a0[4] = {pk[0].x, pk[0].y, pk[0].z, pk[0].w}, a1[4] = {pk[1].x, pk[1].y, pk[1].z, pk[1].w};
#pragma unroll
                for (int jj = 0; jj < 4; ++jj) {
                    *(LAS unsigned*)(L + GL_KT + (8 * k_ch0 + 2 * jj) * 72 + 4 * k_rp) = (a0[jj] & 0xffffu) | (a1[jj] << 16);
                    *(LAS unsigned*)(L + GL_KT + (8 * k_ch0 + 2 * jj + 1) * 72 + 4 * k_rp) = (a0[jj] >> 16) | (a1[jj] & 0xffff0000u); }
                if (t < 256) {
                    *(LAS v4u*)(L + GL_KL + r0 * 768 + 16 * (k_ch1 ^ (r0 & 15))) = pk[2];
                    *(LAS v4u*)(L + GL_KL + r1 * 768 + 16 * (k_ch1 ^ (r1 & 15))) = pk[3];
                    const unsigned b0[4] = {pk[2].x, pk[2].y, pk[2].z, pk[2].w}, b1[4] = {pk[3].x, pk[3].y, pk[3].z, pk[3].w};
#pragma unroll
                    for (int jj = 0; jj < 4; ++jj) {
                        *(LAS unsigned*)(L + GL_KT + (8 * k_ch1 + 2 * jj) * 72 + 4 * k_rp) = (b0[jj] & 0xffffu) | (b1[jj] << 16);
                        *(LAS unsigned*)(L + GL_KT + (8 * k_ch1 + 2 * jj + 1) * 72 + 4 * k_rp) = (b0[jj] >> 16) | (b1[jj] & 0xffff0000u); }
                }
                if (t < 128) {
                    const unsigned c0[4] = {pv[0].x, pv[0].y, pv[0].z, pv[0].w}, c1[4] = {pv[1].x, pv[1].y, pv[1].z, pv[1].w};
#pragma unroll
                    for (int jj = 0; jj < 4; ++jj) {
                        *(LAS unsigned*)(L + GL_VT + (8 * v_ch + 2 * jj) * 72 + 4 * v_rp) = (c0[jj] & 0xffffu) | (c1[jj] << 16);
                        *(LAS unsigned*)(L + GL_VT + (8 * v_ch + 2 * jj + 1) * 72 + 4 * v_rp) = (c0[jj] >> 16) | (c1[jj] & 0xffff0000u); }
                }
            }
            f32x4 ebv[3][2];
            { const float* eb = C.EBL + (size_t)(b * 64 + s) * DKT + h * DKH;
#pragma unroll
                for (int p = 0; p < 3; ++p)
#pragma unroll
                    for (int hf = 0; hf < 2; ++hf) ebv[p][hf] = *(const f32x4*)(eb + 32 * (3 * dg + p) + 16 * hf + 4 * g); }
            __builtin_amdgcn_sched_barrier(0);
            GLA_PREFETCH(s + 1 < 64 ? s + 1 : 63);
            __builtin_amdgcn_sched_barrier(0);
            asm volatile("s_waitcnt lgkmcnt(0)" ::: "memory"); __builtin_amdgcn_s_barrier(); asm volatile("" ::: "memory");
            if (w < 3) {
                const int it = (w >= 1) ? 1 : 0, jt = (w == 2) ? 1 : 0;
                f32x4 pa = (f32x4){0.f, 0.f, 0.f, 0.f};
                const int rj = 16 * jt + c, ri = 16 * it + c;
#pragma unroll
                for (int kb = 0; kb < 2; ++kb) {
                    bf16x8 af[6], bf[6];
#pragma unroll
                    for (int q = 0; q < 6; ++q) { const int ks = 6 * kb + q;
                        af[q] = *(const LAS bf16x8*)(L + GL_KL + rj * 768 + 16 * ((4 * ks + g) ^ (rj & 15)));
                        bf[q] = *(const LAS bf16x8*)(L + GL_QL + ri * 768 + 16 * ((4 * ks + g) ^ (ri & 15))); }
                    __builtin_amdgcn_sched_barrier(0);
#pragma unroll
                    for (int q = 0; q < 6; ++q) pa = __builtin_amdgcn_mfma_f32_16x16x32_bf16(af[q], bf[q], pa, 0, 0, 0);
                    __builtin_amdgcn_sched_barrier(0);
                }
                if (it == jt) {
#pragma unroll
                    for (int r = 0; r < 4; ++r) if (4 * g + r > c) pa[r] = 0.f;
                }
                v2u pw; pw.x = pg8::cvt_pk_bf16(pa[0], pa[1]); pw.y = pg8::cvt_pk_bf16(pa[2], pa[3]);
                *(LAS v2u*)(L + GL_P + ri * 72 + (16 * jt + 4 * g) * 2) = pw;
            }
            f32x4 O[2][2];
#pragma unroll
            for (int it = 0; it < 2; ++it)
#pragma unroll
                for (int et = 0; et < 2; ++et) O[it][et] = (f32x4){0.f, 0.f, 0.f, 0.f};
            {
                v2u qlo[3][2], qhi[3][2];
#pragma unroll
                for (int p = 0; p < 3; ++p) { const int cb = 4 * (3 * dg + p);
#pragma unroll
                    for (int it = 0; it < 2; ++it) { const int ri = 16 * it + c;
                        qlo[p][it] = *(const LAS v2u*)(L + GL_QL + ri * 768 + 16 * ((cb + (g >> 1)) ^ (ri & 15)) + 8 * (g & 1));
                        qhi[p][it] = *(const LAS v2u*)(L + GL_QL + ri * 768 + 16 * ((cb + 2 + (g >> 1)) ^ (ri & 15)) + 8 * (g & 1)); } }
                bf16x8 Bf[3][2];
#pragma unroll
                for (int p = 0; p < 3; ++p)
#pragma unroll
                    for (int et = 0; et < 2; ++et) { v4u x; x.x = pg8::cvt_pk_bf16(R[p][0][et][0], R[p][0][et][1]); x.y = pg8::cvt_pk_bf16(R[p][0][et][2], R[p][0][et][3]);
                        x.z = pg8::cvt_pk_bf16(R[p][1][et][0], R[p][1][et][1]); x.w = pg8::cvt_pk_bf16(R[p][1][et][2], R[p][1][et][3]); Bf[p][et] = __builtin_bit_cast(bf16x8, x); }
                __builtin_amdgcn_sched_barrier(0);
#pragma unroll
                for (int p = 0; p < 3; ++p)
#pragma unroll
                    for (int it = 0; it < 2; ++it) { const bf16x8 a = mk_frag(qlo[p][it], qhi[p][it]);
#pragma unroll
                        for (int et = 0; et < 2; ++et) O[it][et] = __builtin_amdgcn_mfma_f32_16x16x32_bf16(a, Bf[p][et], O[it][et], 0, 0, 0); }
            }
            asm volatile("s_waitcnt lgkmcnt(0)" ::: "memory"); __builtin_amdgcn_s_barrier(); asm volatile("" ::: "memory");
            bf16x8 Vf[2];
#pragma unroll
            for (int et = 0; et < 2; ++et) { const int e = 32 * eh + 16 * et + c;
                Vf[et] = mk_frag(*(const LAS v2u*)(L + GL_VT + e * 72 + 16 * g), *(const LAS v2u*)(L + GL_VT + e * 72 + 16 * g + 8)); }
            if (dg == 0) {
#pragma unroll
                for (int it = 0; it < 2; ++it) { const int ri = 16 * it + c;
                    const bf16x8 a = mk_frag(*(const LAS v2u*)(L + GL_P + ri * 72 + 16 * g), *(const LAS v2u*)(L + GL_P + ri * 72 + 16 * g + 8));
#pragma unroll
                    for (int et = 0; et < 2; ++et) O[it][et] = __builtin_amdgcn_mfma_f32_16x16x32_bf16(a, Vf[et], O[it][et], 0, 0, 0); }
            }
#pragma unroll
            for (int it = 0; it < 2; ++it)
#pragma unroll
                for (int et = 0; et < 2; ++et)
#pragma unroll
                    for (int r = 0; r < 4; ++r) *(LAS float*)(L + GL_OS + ((dg * 32 + 16 * it + 4 * g + r) * 64 + 32 * eh + 16 * et + c) * 4) = O[it][et][r];
            {
                v2u klo[3][2], khi[3][2];
#pragma unroll
                for (int p = 0; p < 3; ++p)
#pragma unroll
                    for (int hf = 0; hf < 2; ++hf) { const int d = 32 * (3 * dg + p) + 16 * hf + c;
                        klo[p][hf] = *(const LAS v2u*)(L + GL_KT + d * 72 + 16 * g); khi[p][hf] = *(const LAS v2u*)(L + GL_KT + d * 72 + 16 * g + 8); }
                __builtin_amdgcn_sched_barrier(0);
#pragma unroll
                for (int p = 0; p < 3; ++p)
#pragma unroll
                    for (int hf = 0; hf < 2; ++hf) { const bf16x8 a = mk_frag(klo[p][hf], khi[p][hf]);
#pragma unroll
                        for (int et = 0; et < 2; ++et) R[p][hf][et] = __builtin_amdgcn_mfma_f32_16x16x32_bf16(a, Vf[et], R[p][hf][et], 0, 0, 0); }
            }
            asm volatile("s_waitcnt lgkmcnt(0)" ::: "memory"); __builtin_amdgcn_s_barrier(); asm volatile("" ::: "memory");
            { const int i = t >> 4, e4 = (t & 15) * 4;
                f32x4 o = *(const LAS f32x4*)(L + GL_OS + ((0 * 32 + i) * 64 + e4) * 4);
#pragma unroll
                for (int q = 1; q < 4; ++q) o += *(const LAS f32x4*)(L + GL_OS + ((q * 32 + i) * 64 + e4) * 4);
                *(v2u*)(C.OB + (size_t)(b * SEQ + 32 * s + i) * DVT + h * DVH + 64 * es + e4) = (v2u){pg8::cvt_pk_bf16(o.x, o.y), pg8::cvt_pk_bf16(o.z, o.w)}; }
#pragma unroll
            for (int p = 0; p < 3; ++p)
#pragma unroll
                for (int hf = 0; hf < 2; ++hf)
#pragma unroll
                    for (int et = 0; et < 2; ++et) R[p][hf][et] *= ebv[p][hf];
        }
#undef GLA_PREFETCH
#pragma unroll
        for (int p = 0; p < 3; ++p)
#pragma unroll
            for (int hf = 0; hf < 2; ++hf)
#pragma unroll
                for (int et = 0; et < 2; ++et)
#pragma unroll
                    for (int r = 0; r < 4; ++r)
                        C.out[OFF_GLAP + ((size_t)(b * 4 + h) * DKH + 32 * (3 * dg + p) + 16 * hf + 4 * g + r) * DVH + 64 * es + 32 * eh + 16 * et + c] = R[p][hf][et][r];
        __syncthreads();
    }
}

__device__ __forceinline__ void p6_finalize(const Ctx& C) {
    const int lane = lane_fresh();
    const bool hi = lane >= 32;
    for (int row = C.gw; row < MT; row += C.NGW) {
        const v4u* op = (const v4u*)(C.OB + (size_t)row * DVT) + lane;
        const v4u* gp = (const v4u*)(C.Z + (size_t)row * ZW + ZC_G) + lane;
        v4u ov[6], gv[6];
#pragma unroll
        for (int jj = 0; jj < 6; ++jj) ov[jj] = op[64 * jj];
#pragma unroll
        for (int jj = 0; jj < 6; ++jj) gv[jj] = gp[64 * jj];
        float ss[6];
#pragma unroll
        for (int jj = 0; jj < 6; ++jj) { const float a0 = bflo(ov[jj].x), a1 = bfhi(ov[jj].x), a2 = bflo(ov[jj].y), a3 = bfhi(ov[jj].y), a4 = bflo(ov[jj].z), a5 = bfhi(ov[jj].z), a6 = bflo(ov[jj].w), a7 = bfhi(ov[jj].w);
            ss[jj] = ((a0 * a0 + a1 * a1) + (a2 * a2 + a3 * a3)) + ((a4 * a4 + a5 * a5) + (a6 * a6 + a7 * a7)); }
        const float q0 = wave_sum(ss[0] + (hi ? 0.f : ss[1])), q1 = wave_sum((hi ? ss[1] : 0.f) + ss[2]), q2 = wave_sum(ss[3] + (hi ? 0.f : ss[4])), q3 = wave_sum((hi ? ss[4] : 0.f) + ss[5]);
        const float r0 = 1.0f / sqrtf(q0 * (1.0f / DVH) + EPS), r1 = 1.0f / sqrtf(q1 * (1.0f / DVH) + EPS), r2 = 1.0f / sqrtf(q2 * (1.0f / DVH) + EPS), r3 = 1.0f / sqrtf(q3 * (1.0f / DVH) + EPS);
        v4u* mp = (v4u*)(C.MIX + (size_t)row * D + DPOOL) + lane;
#pragma unroll
        for (int jj = 0; jj < 6; ++jj) {
            const float rs = jj == 0 ? r0 : jj == 1 ? (hi ? r1 : r0) : jj == 2 ? r1 : jj == 3 ? r2 : jj == 4 ? (hi ? r3 : r2) : r3;
            const float* gn = C.g_gla_out + 8 * (64 * jj + lane);
            const f32x4 g0 = *(const f32x4*)gn, g1 = *(const f32x4*)(gn + 4);
            const float y0 = pg8::silu_f(bflo(gv[jj].x)) * (bflo(ov[jj].x) * rs * g0.x), y1 = pg8::silu_f(bfhi(gv[jj].x)) * (bfhi(ov[jj].x) * rs * g0.y);
            const float y2 = pg8::silu_f(bflo(gv[jj].y)) * (bflo(ov[jj].y) * rs * g0.z), y3 = pg8::silu_f(bfhi(gv[jj].y)) * (bfhi(ov[jj].y) * rs * g0.w);
            const float y4 = pg8::silu_f(bflo(gv[jj].z)) * (bflo(ov[jj].z) * rs * g1.x), y5 = pg8::silu_f(bfhi(gv[jj].z)) * (bfhi(ov[jj].z) * rs * g1.y);
            const float y6 = pg8::silu_f(bflo(gv[jj].w)) * (bflo(ov[jj].w) * rs * g1.z), y7 = pg8::silu_f(bfhi(gv[jj].w)) * (bfhi(ov[jj].w) * rs * g1.w);
            mp[64 * jj] = (v4u){pk2(y0, y1), pk2(y2, y3), pk2(y4, y5), pk2(y6, y7)}; }
    }
}

__device__ __forceinline__ void p11_final_norm(const Ctx& C) {
    const int lane = lane_fresh();
    for (int row = C.gw; row < TP; row += C.NGW) {
        const v4u* xv = (const v4u*)(C.OPB + (size_t)row * D) + lane;
        v4u w[8]; float s = 0.f;
#pragma unroll
        for (int j = 0; j < 8; ++j) w[j] = xv[64 * j];
#pragma unroll
        for (int j = 0; j < 8; ++j) { const float a0 = bflo(w[j].x), a1 = bfhi(w[j].x), a2 = bflo(w[j].y), a3 = bfhi(w[j].y), a4 = bflo(w[j].z), a5 = bfhi(w[j].z), a6 = bflo(w[j].w), a7 = bfhi(w[j].w);
            s += ((a0 * a0 + a1 * a1) + (a2 * a2 + a3 * a3)) + ((a4 * a4 + a5 * a5) + (a6 * a6 + a7 * a7)); }
        const float rstd = 1.0f / sqrtf(wave_sum(s) * (1.0f / D) + EPS);
        float* orow = C.out + (size_t)row * D;
#pragma unroll
        for (int j = 0; j < 8; ++j) { const int c = 8 * (64 * j + lane);
            const f32x4 g0 = *(const f32x4*)(C.g_final + c), g1 = *(const f32x4*)(C.g_final + c + 4);
            const f32x4 x0 = (f32x4){bflo(w[j].x), bfhi(w[j].x), bflo(w[j].y), bfhi(w[j].y)}, x1 = (f32x4){bflo(w[j].z), bfhi(w[j].z), bflo(w[j].w), bfhi(w[j].w)};
            *(f32x4*)(orow + c) = x0 * rstd * g0; *(f32x4*)(orow + c + 4) = x1 * rstd * g1; }
    }
    const int t = threadIdx.x, w = C.wave;
    for (int n = blockIdx.x; n < NS; n += C.G) {
        const int row = TP + n;
        f32x4 v[2]; float ssq;
        sample_row_from_slabs<16>(C.X1 + (size_t)row * D, C.MOD + (size_t)(4 + n) * NMOD + 5 * D, C.XS, n, v, ssq, (LAS float*)C.lds, t, w);
        const float rstd = 1.0f / sqrtf(ssq * (1.0f / D) + EPS);
#pragma unroll
        for (int j = 0; j < 2; ++j) { const int c = 4 * t + 2048 * j;
            *(f32x4*)(C.out + (size_t)row * D + c) = v[j] * rstd * *(const f32x4*)(C.g_final + c); }
    }
}

__device__ __forceinline__ void p9_fixup(const Ctx& C) {
    const int nth = C.G * NWAVES * 64;
    for (int it = blockIdx.x * NWAVES * 64 + threadIdx.x; it < NS * (OV_COLS / 8); it += nth) {
        const int n = it / (OV_COLS / 8), col = (it % (OV_COLS / 8)) * 8;
        f32x4 a0 = (f32x4){0.f, 0.f, 0.f, 0.f}, a1 = a0, b0 = a0, b1 = a0;
#pragma unroll
        for (int ks = 0; ks < OV_KS; ++ks) { const float* pa = C.SS + ((size_t)(ks * 2) * NS + n) * OV_COLS + col; const float* pb = pa + (size_t)NS * OV_COLS;
            a0 += *(const f32x4*)pa; a1 += *(const f32x4*)(pa + 4); b0 += *(const f32x4*)pb; b1 += *(const f32x4*)(pb + 4); }
        v4u w;
        w.x = pg8::cvt_pk_bf16(pg8::silu_f(a0.x) * b0.x, pg8::silu_f(a0.y) * b0.y); w.y = pg8::cvt_pk_bf16(pg8::silu_f(a0.z) * b0.z, pg8::silu_f(a0.w) * b0.w);
        w.z = pg8::cvt_pk_bf16(pg8::silu_f(a1.x) * b1.x, pg8::silu_f(a1.y) * b1.y); w.w = pg8::cvt_pk_bf16(pg8::silu_f(a1.z) * b1.z, pg8::silu_f(a1.w) * b1.w);
        const int blk = col >> 7, pn = blk < OV_N / 2 ? OV_PA + blk : OV_PB + blk;
        *(v4u*)(C.ACT + (size_t)(TP + n) * DFF + pn * 128 + (col & 127)) = w;
    }
}

struct Args { const float* in[21]; float* out; unsigned char* ws; int ph_lo, ph_hi, li, pad; };
__global__ void __launch_bounds__(NWAVES * 64, 2) fwd_kernel(Args args) {
    extern __shared__ __attribute__((aligned(16))) unsigned char lds[];
    Ctx C;
    C.lds = (LAS unsigned char*)lds;
    C.wave = __builtin_amdgcn_readfirstlane(threadIdx.x >> 6);
    C.G = gridDim.x; C.gw = blockIdx.x * NWAVES + C.wave; C.NGW = C.G * NWAVES;
    C.x_prompt = args.in[0]; C.x_sample = args.in[1]; C.state_pool = args.in[2]; C.state_gla = args.in[3]; C.c_prompt = args.in[4]; C.c_sample = args.in[5];
    C.w_ada = args.in[6]; C.b_ada = args.in[7]; C.g_norm1 = args.in[8]; C.w_in = args.in[9]; C.w_pool = args.in[10]; C.pool_scale = args.in[11]; C.w_a2 = args.in[12];
    C.b_a = args.in[13]; C.g_gla_out = args.in[14]; C.w_out = args.in[15]; C.g_norm2 = args.in[16]; C.w_ff1 = args.in[17]; C.w_ff3 = args.in[18]; C.w_ff2 = args.in[19]; C.g_final = args.in[20];
    C.out = args.out;
    unsigned char* ws = args.ws;
    C.MOD = (float*)(ws + WS_MOD); C.SC = (bf16*)(ws + WS_SC); C.WinT = (bf16*)(ws + WS_WIN); C.WaT = (bf16*)(ws + WS_WA); C.WoutT = (bf16*)(ws + WS_WOUT);
    C.W13T = (bf16*)(ws + WS_W13); C.Wff2T = (bf16*)(ws + WS_WFF2); C.WpT = (bf16*)(ws + WS_WP); C.H = (bf16*)(ws + WS_H); C.Z = (bf16*)(ws + WS_Z);
    C.QT = (bf16*)(ws + WS_QT); C.KT = (bf16*)(ws + WS_KT); C.EBL = (float*)(ws + WS_EBL); C.LAS_ = (float*)(ws + WS_LAS); C.DP = (bf16*)(ws + WS_DP);
    C.OB = (bf16*)(ws + WS_OB); C.MIX = (bf16*)(ws + WS_MIX); C.X1 = (float*)(ws + WS_X1); C.X1B = (bf16*)(ws + WS_X1); C.OPB = (bf16*)(ws + WS_X1 + (size_t)TP * D * 2); C.ACT = (bf16*)(ws + WS_ACT); C.ZS = (float*)(ws + WS_ZS); C.XS = (float*)(ws + WS_XS); C.SS = (float*)(ws + WS_SS);
    volatile LAS unsigned* MISC = (volatile LAS unsigned*)(C.lds + MISC_OFF);
    for (int u = threadIdx.x; u < (LDS_BYTES - MISC_OFF) / 4; u += NWAVES * 64) MISC[u] = 0u;
    __syncthreads();
    unsigned* ctl = (unsigned*)(ws + WS_CTL);
    XcdBarrier bar; bar.bar = ctl + CW_BAR; bar.x = 0; bar.st = nullptr;
    if (MK_LAUNCHES == 1) bar = xcd_barrier_post(ctl + CW_BAR, MISC + 8);
#define GRID_BAR() do { if (MK_LAUNCHES == 1) xcd_barrier(bar); } while (0)
    const int lo = args.ph_lo, hi = args.ph_hi;
#define IN(k) (lo <= (k) && (k) < hi)
#define BOTH(k) (IN(k) && IN((k) + 1))

#define DUP(k) ((PROBE_DUP >> (k)) & 1)
    if (IN(0)) { p0_small(C); if (BOTH(0)) GRID_BAR(); }
    if (IN(1)) { p1_adaln(C); if (DUP(1)) { GRID_BAR(); p1_adaln(C); } if (BOTH(1)) GRID_BAR(); }
    if (IN(2)) { norm_rows<false>(C, C.x_prompt, nullptr, C.x_sample, C.g_norm1, 0, D, C.H, nullptr, 0, nullptr); if (DUP(2)) { GRID_BAR(); norm_rows<false>(C, C.x_prompt, nullptr, C.x_sample, C.g_norm1, 0, D, C.H, nullptr, 0, nullptr); } if (BOTH(2)) GRID_BAR(); }
    if (IN(3)) {
        pg8::Gemm g{C.H, C.WinT, D, D, 0}; pg8::TwoPartOrder S; S.init(TP / 256, ZW / 256, D / 64, 4, 16, 16, 4, C.G, (int)blockIdx.x);
        pg8::EpiZ E{C.Z, ZW, C.ZS};
        pg8::gemm_phase<pg8::EpiZ, pg8::TwoPartOrder, true, true>(C.lds, g, S, E);
        if (DUP(3)) { GRID_BAR(); pg8::gemm_phase<pg8::EpiZ, pg8::TwoPartOrder, true, true>(C.lds, g, S, E); }
        if (BOTH(3)) GRID_BAR();
    }
    if (IN(4)) { p4_prep(C); if (DUP(4)) { GRID_BAR(); p4_prep(C); } if (BOTH(4)) GRID_BAR(); }
    if (IN(5)) { p5_gla_prompt(C); if (DUP(5)) { GRID_BAR(); p5_gla_prompt(C); } p5_sample_pool(C); p5_gla_sample_q(C, ctl + CW_Q); if (BOTH(5)) GRID_BAR(); }
    if (IN(6)) {
        p6_finalize(C);
        __syncthreads();
        pg8::Gemm g{C.DP, C.WpT, DPOOL, 256, 256}; pg8::TwoPartOrder S; S.init(MP / 256, 4, 4, 0, 0, 0, 0, C.G, (int)blockIdx.x);
        pg8::EpiPool E{C.MIX, D, C.pool_scale};
        pg8::gemm_phase<pg8::EpiPool, pg8::TwoPartOrder, true, true>(C.lds, g, S, E);
        if (DUP(6)) { GRID_BAR(); p6_finalize(C); __syncthreads(); pg8::gemm_phase<pg8::EpiPool, pg8::TwoPartOrder, true, true>(C.lds, g, S, E); }
        if (BOTH(6)) GRID_BAR();
    }
    if (IN(7)) {
        pg8::Gemm g{C.MIX, C.WoutT, D, D, 0}; pg8::TwoPartOrder S; S.init(TP / 256, D / 256, D / 64, 8, 8, 8, 8, C.G, (int)blockIdx.x);
        pg8::EpiResB<false> E{C.x_prompt, nullptr, C.MOD + 2 * D, C.X1B, C.XS};
        pg8::gemm_phase<pg8::EpiResB<false>, pg8::TwoPartOrder, true, true>(C.lds, g, S, E);
        if (DUP(7)) { GRID_BAR(); pg8::gemm_phase<pg8::EpiResB<false>, pg8::TwoPartOrder, true, true>(C.lds, g, S, E); }
        if (BOTH(7)) GRID_BAR();
    }
    if (IN(8)) { norm_rows<true>(C, nullptr, C.X1B, C.x_sample, C.g_norm2, 3 * D, 4 * D, C.H, C.XS, 2 * D, C.X1); if (DUP(8)) { GRID_BAR(); norm_rows<true>(C, nullptr, C.X1B, C.x_sample, C.g_norm2, 3 * D, 4 * D, C.H, C.XS, 2 * D, C.X1); } if (BOTH(8)) GRID_BAR(); }
    if (IN(9)) {
        pg8::Gemm g{C.H, C.W13T, D, D, 0}; pg8::TwoPartOrder S; S.init(TP / 256, 2 * DFF / 256, D / 64, 1, D / 64, D / 64, 1, C.G, (int)blockIdx.x); S.ovf = (C.G == 256) ? OV_KS : 0;
        pg8::EpiSwiGLU E{C.ACT, DFF, C.SS, OV_SPLIT, OV_PA, OV_PB, OV_COLS};
        pg8::gemm_phase<pg8::EpiSwiGLU, pg8::TwoPartOrder, true, true>(C.lds, g, S, E);
        if (DUP(9)) { GRID_BAR(); pg8::gemm_phase<pg8::EpiSwiGLU, pg8::TwoPartOrder, true, true>(C.lds, g, S, E); }
        if (BOTH(9)) GRID_BAR();
    }
    if (IN(10) && C.G == 256) { p9_fixup(C); GRID_BAR(); }
    if (IN(10)) {
        pg8::Gemm g{C.ACT, C.Wff2T, DFF, DFF, 0}; pg8::TwoPartOrder S; S.init(TP / 256, D / 256, DFF / 64, 16, 12, 10, 6, C.G, (int)blockIdx.x, C.G == 256 ? 1 : 0);
        pg8::EpiResB<true> E{nullptr, C.X1B, C.MOD + 5 * D, C.OPB, C.XS};
        pg8::gemm_phase<pg8::EpiResB<true>, pg8::TwoPartOrder, true, true>(C.lds, g, S, E);
        if (DUP(10)) { GRID_BAR(); pg8::gemm_phase<pg8::EpiResB<true>, pg8::TwoPartOrder, true, true>(C.lds, g, S, E); }
        if (BOTH(10)) GRID_BAR();
    }
    if (IN(11)) { p11_final_norm(C); }
#undef IN
#undef BOTH
}

extern "C" void kernel_launch(void* const* d_in, const int* in_sizes, int n_in, void* d_out, int out_size, void* d_ws, size_t ws_size, hipStream_t stream) {
    static int grid = 0;
    if (grid == 0) {
        if (n_in != 21 || ws_size < WS_END) { fprintf(stderr, "kernel_launch: unexpected shapes (n_in %d, ws %zu < %zu)\n", n_in, ws_size, (size_t)WS_END); grid = -1; return; }
        int dev = 0, cus = 0, per_cu = 0;
        if (hipGetDevice(&dev) != hipSuccess || hipDeviceGetAttribute(&cus, hipDeviceAttributeMultiprocessorCount, dev) != hipSuccess) { grid = -1; return; }
        if (hipFuncSetAttribute((const void*)fwd_kernel, hipFuncAttributeMaxDynamicSharedMemorySize, LDS_BYTES) != hipSuccess) { fprintf(stderr, "kernel_launch: hipFuncSetAttribute failed\n"); grid = -1; return; }
        if (hipOccupancyMaxActiveBlocksPerMultiprocessor(&per_cu, (const void*)fwd_kernel, NWAVES * 64, LDS_BYTES) != hipSuccess || per_cu < 1)
            fprintf(stderr, "kernel_launch: occupancy query reports %d workgroups per CU\n", per_cu);
        (void)hipGetLastError();
        grid = cus;
    }
    if (grid < 0) return;
    if (hipMemsetAsync((char*)d_ws + WS_CTL, 0, CTL_ZERO_BYTES, stream) != hipSuccess) return;
    Args a{};
    for (int i = 0; i < 21; ++i) a.in[i] = (const float*)d_in[i];
    a.out = (float*)d_out; a.ws = (unsigned char*)d_ws; a.pad = 0;
    for (int li = 0; li < MK_LAUNCHES; ++li) {
        if (MK_LAUNCHES == 1) { a.ph_lo = 0; a.ph_hi = NPHASES; } else { a.ph_lo = li; a.ph_hi = li + 1; }
        a.li = li;
        hipLaunchKernelGGL(fwd_kernel, dim3(grid), dim3(NWAVES * 64), LDS_BYTES, stream, a);
        if (hipPeekAtLastError() != hipSuccess) { fprintf(stderr, "kernel_launch: launch %d failed\n", li); break; }
    }
}
```

```cpp
#include <hip/hip_runtime.h>
#include <cstdio>
#include <cstdint>

#ifndef PROBE_REP6
#define PROBE_REP6 0
#endif
#ifndef PROBE_DUP
#define PROBE_DUP 0
#endif
#ifndef MK_LAUNCHES
#define MK_LAUNCHES 1
#endif

namespace pg8 {
#define PG8_LAS __attribute__((address_space(3)))
typedef unsigned short bf16_t;
typedef short bf16x8 __attribute__((ext_vector_type(8)));
typedef float f32x4 __attribute__((ext_vector_type(4)));
typedef unsigned u32x4 __attribute__((ext_vector_type(4)));
constexpr int BM = 256, BK = 64, HALF = 128, HTB = HALF * BK * 2  , STAGE_BYTES = 8 * HTB, NXCD = 8, WGM = 8;

__host__ __device__ __forceinline__ int lds_byte(int r, int c) { const int st = (r >> 4) * 2 + (c >> 5), rr = r & 15, cc = c & 31, ob = rr * 64 + cc * 2; return st * 1024 + (ob ^ (((ob >> 9) & 1) << 5)); }
__host__ __device__ __forceinline__ void stage_rc(int b, int& R, int& C) { const int st = b / 1024, sb = b % 1024, swz = sb ^ (((sb >> 9) & 1) << 5); R = (st >> 1) * 16 + swz / 64; C = (st & 1) * 32 + (swz % 64) / 2; }
__host__ __device__ __forceinline__ int perm32(int rho) { const int n = rho >> 4, i = rho & 15; return 8 * (i >> 2) + 4 * n + (i & 3); }

struct Unit { int pm, pn, kb, nkt, ks; bool half, ksp; };
struct Gemm { const bf16_t* A; const bf16_t* Bt; int lda, ldb, a_pn_off; };

struct TwoPartOrder {
    int nMp, nN, nP, nS, G, c, KT, nks, kt_a, kt_b, n_a, early, ovf;
    __host__ __device__ void init(int nMp_, int nN_, int KT_, int nks_, int kt_a_, int kt_b_, int n_a_, int G_, int c_, int early_ = 0) {
        early = early_; ovf = 0; nMp = nMp_; nN = nN_; nP = nMp * nN; KT = KT_; nks = nks_; kt_a = kt_a_; kt_b = kt_b_; n_a = n_a_; nS = nN * nks; G = G_; c = c_; }
    __host__ __device__ bool next(int i, Unit& u) const {
        if (early && (c & 1)) {
            if (i == 0) { u.pm = nMp; u.pn = c % nN; u.ks = c / nN; u.half = true; u.ksp = false; u.kb = u.ks < n_a ? u.ks * kt_a : n_a * kt_a + (u.ks - n_a) * kt_b; u.nkt = u.ks < n_a ? kt_a : kt_b; return true; }
            i -= 1;
            if ((long)i * G + c >= nP) return false;
        }
        const long L = (long)i * G + c;
        if (L < nP) {
            int wgid = (int)L; { const int q = nP / NXCD, r = nP % NXCD, xcd = wgid % NXCD, off = wgid / NXCD; wgid = (xcd < r ? xcd * (q + 1) : r * (q + 1) + (xcd - r) * q) + off; }
            const int nig = WGM * nN, gid = wgid / nig, fm = gid * WGM, gsz = (nMp - fm) < WGM ? (nMp - fm) : WGM;
            u.pm = fm + ((wgid % nig) % gsz); u.pn = (wgid % nig) / gsz; u.kb = 0; u.nkt = KT; u.ks = 0; u.half = false; u.ksp = false; return true;
        }
        const int shift = nP % G, i0 = nP / G, m = i - i0, cr = (c - shift + G) % G;
        if (ovf > 0 && m >= 1) {
            const int J0 = G - shift, q = (m - 1) * G + c;
            if (q >= (nS - J0) * ovf) return false;
            const int k = q / ovf, nh = (nS - J0) / 2;
            u.pm = nMp; u.pn = k < nh ? nN / 2 - nh + k : nN - 2 * nh + k; u.ks = q % ovf; u.half = true; u.ksp = true; u.nkt = KT / ovf; u.kb = u.ks * u.nkt; return true;
        }
        const int j = (m == 0) ? cr : (G - shift) + (m - 1) * G + cr;
        if (j >= nS) return false;
        u.pm = nMp; u.pn = j % nN; u.ks = j / nN; u.half = true; u.ksp = false;
        if (ovf > 0) { const int nh = (nS - (G - shift)) / 2; u.pn = j < nN / 2 - nh ? j : j + nh; }
        u.kb = u.ks < n_a ? u.ks * kt_a : n_a * kt_a + (u.ks - n_a) * kt_b; u.nkt = u.ks < n_a ? kt_a : kt_b; return true;
    }
    __device__ __forceinline__ void a_ready(const Unit&) const {}
    __device__ __forceinline__ void done(const Unit&) const {}
};

__device__ __forceinline__ unsigned cvt_pk_bf16(float lo, float hi) { unsigned r; asm volatile("v_cvt_pk_bf16_f32 %0, %1, %2" : "=v"(r) : "v"(lo), "v"(hi)); return r; }
__device__ __forceinline__ float silu_f(float x) { return x * __builtin_amdgcn_rcpf(1.0f + __expf(-x)); }

struct EpiZ {
    static constexpr bool PERM = true, AFTER_DRAIN = false;
    bf16_t* O; int ldc; float* slab;
    __device__ __forceinline__ void operator()(const f32x4 (&acc)[2][2][4][2], const Unit& u, int wr, int wc, int fr, int fq) const {
        const int row0 = u.pm * BM + wr * 64 + fr, col0 = u.pn * BM + wc * 32 + 8 * fq;
        if (!u.half) {
#pragma unroll
            for (int ai = 0; ai < 2; ++ai)
#pragma unroll
                for (int m = 0; m < 4; ++m) { bf16_t* rowp = O + (size_t)(row0 + ai * HALF + m * 16) * ldc + col0;
#pragma unroll
                    for (int bj = 0; bj < 2; ++bj) { const f32x4 v0 = acc[ai][bj][m][0], v1 = acc[ai][bj][m][1];
                        u32x4 w; w.x = cvt_pk_bf16(v0[0], v0[1]); w.y = cvt_pk_bf16(v0[2], v0[3]); w.z = cvt_pk_bf16(v1[0], v1[1]); w.w = cvt_pk_bf16(v1[2], v1[3]);
                        *(u32x4*)(rowp + bj * HALF) = w; } }
        } else {
#pragma unroll
            for (int m = 0; m < 4; ++m) { float* rowp = slab + ((size_t)u.ks * 128 + (wr * 64 + fr + m * 16)) * ldc + col0;
#pragma unroll
                for (int bj = 0; bj < 2; ++bj) { *(f32x4*)(rowp + bj * HALF) = acc[0][bj][m][0]; *(f32x4*)(rowp + bj * HALF + 4) = acc[0][bj][m][1]; } }
        }
    }
};
struct EpiPool {
    static constexpr bool PERM = true, AFTER_DRAIN = false;
    bf16_t* O; int ldc; const float* scale;
    __device__ __forceinline__ void operator()(const f32x4 (&acc)[2][2][4][2], const Unit& u, int wr, int wc, int fr, int fq) const {
        const int row0 = u.pm * BM + wr * 64 + fr, col0 = u.pn * BM + wc * 32 + 8 * fq;
        f32x4 sv[2][2];
#pragma unroll
        for (int bj = 0; bj < 2; ++bj)
#pragma unroll
            for (int n = 0; n < 2; ++n) sv[bj][n] = *(const f32x4*)(scale + col0 + bj * HALF + 4 * n);
#pragma unroll
        for (int ai = 0; ai < 2; ++ai)
#pragma unroll
            for (int m = 0; m < 4; ++m) { bf16_t* rowp = O + (size_t)(row0 + ai * HALF + m * 16) * ldc + col0;
#pragma unroll
                for (int bj = 0; bj < 2; ++bj) { const f32x4 v0 = acc[ai][bj][m][0] * sv[bj][0], v1 = acc[ai][bj][m][1] * sv[bj][1];
                    u32x4 w; w.x = cvt_pk_bf16(v0[0], v0[1]); w.y = cvt_pk_bf16(v0[2], v0[3]); w.z = cvt_pk_bf16(v1[0], v1[1]); w.w = cvt_pk_bf16(v1[2], v1[3]);
                    *(u32x4*)(rowp + bj * HALF) = w; } }
    }
};
struct EpiSwiGLU {
    static constexpr bool PERM = true, AFTER_DRAIN = false;
    bf16_t* O; int ldc; float* slab; int psplit, pa, pb, lds_;
    __device__ __forceinline__ void operator()(const f32x4 (&acc)[2][2][4][2], const Unit& u, int wr, int wc, int fr, int fq) const {
        const int row0 = u.pm * BM + wr * 64 + fr, col0 = u.pn * HALF + wc * 32 + 8 * fq;
        if (!u.ksp) {
#pragma unroll
            for (int ai = 0; ai < 2; ++ai) {
                if (ai == 1 && u.half) break;
#pragma unroll
                for (int m = 0; m < 4; ++m) { bf16_t* rowp = O + (size_t)(row0 + ai * HALF + m * 16) * ldc + col0;
                    const f32x4 a0 = acc[ai][0][m][0], a1 = acc[ai][0][m][1], b0 = acc[ai][1][m][0], b1 = acc[ai][1][m][1];
                    float o[8];
#pragma unroll
                    for (int j = 0; j < 4; ++j) { o[j] = silu_f(a0[j]) * b0[j]; o[4 + j] = silu_f(a1[j]) * b1[j]; }
                    u32x4 w; w.x = cvt_pk_bf16(o[0], o[1]); w.y = cvt_pk_bf16(o[2], o[3]); w.z = cvt_pk_bf16(o[4], o[5]); w.w = cvt_pk_bf16(o[6], o[7]);
                    *(u32x4*)rowp = w; } }
        } else {
            const int cs = (u.pn - (u.pn < psplit ? pa : pb)) * HALF + wc * 32 + 8 * fq;
#pragma unroll
            for (int m = 0; m < 4; ++m)
#pragma unroll
                for (int bj = 0; bj < 2; ++bj) { float* rowp = slab + ((size_t)(u.ks * 2 + bj) * 128 + (wr * 64 + fr + m * 16)) * lds_ + cs;
                    *(f32x4*)rowp = acc[0][bj][m][0]; *(f32x4*)(rowp + 4) = acc[0][bj][m][1]; }
        }
    }
};
template <bool XBF>
struct EpiResB {
    static constexpr bool PERM = true, AFTER_DRAIN = false;
    const float* xf; const bf16_t* xb; const float* gate;
    bf16_t* O; float* slab;
    __device__ __forceinline__ void operator()(const f32x4 (&acc)[2][2][4][2], const Unit& u, int wr, int wc, int fr, int fq) const {
        const int row0 = u.pm * BM + wr * 64 + fr, col0 = u.pn * BM + wc * 32 + 8 * fq;
        if (!u.half) {
            const float* gr = gate + (size_t)((u.pm * BM) >> 11) * 24576 + col0;
            f32x4 gv[2][2];
#pragma unroll
            for (int bj = 0; bj < 2; ++bj)
#pragma unroll
                for (int n = 0; n < 2; ++n) gv[bj][n] = *(const f32x4*)(gr + bj * HALF + 4 * n);
#pragma unroll
            for (int ai = 0; ai < 2; ++ai)
#pragma unroll
                for (int m = 0; m < 4; ++m) { const int row = row0 + ai * HALF + m * 16;
                    bf16_t* orow = O + (size_t)row * 4096 + col0;
                    f32x4 xv[2][2];
                    if (XBF) { const bf16_t* xr = xb + (size_t)row * 4096 + col0;
#pragma unroll
                        for (int bj = 0; bj < 2; ++bj) { const u32x4 w = *(const u32x4*)(xr + bj * HALF);
                            xv[bj][0] = (f32x4){__uint_as_float(w.x << 16), __uint_as_float(w.x & 0xffff0000u), __uint_as_float(w.y << 16), __uint_as_float(w.y & 0xffff0000u)};
                            xv[bj][1] = (f32x4){__uint_as_float(w.z << 16), __uint_as_float(w.z & 0xffff0000u), __uint_as_float(w.w << 16), __uint_as_float(w.w & 0xffff0000u)}; }
                    } else { const float* xr = xf + (size_t)row * 4096 + col0;
#pragma unroll
                        for (int bj = 0; bj < 2; ++bj)
#pragma unroll
                            for (int n = 0; n < 2; ++n) xv[bj][n] = *(const f32x4*)(xr + bj * HALF + 4 * n); }
#pragma unroll
                    for (int bj = 0; bj < 2; ++bj) { const f32x4 v0 = xv[bj][0] + gv[bj][0] * acc[ai][bj][m][0], v1 = xv[bj][1] + gv[bj][1] * acc[ai][bj][m][1];
                        u32x4 w; w.x = cvt_pk_bf16(v0[0], v0[1]); w.y = cvt_pk_bf16(v0[2], v0[3]); w.z = cvt_pk_bf16(v1[0], v1[1]); w.w = cvt_pk_bf16(v1[2], v1[3]);
                        *(u32x4*)(orow + bj * HALF) = w; }
                    if (m & 1) asm volatile("" ::: "memory"); }
        } else {
#pragma unroll
            for (int m = 0; m < 4; ++m) { float* rowp = slab + ((size_t)u.ks * 128 + (wr * 64 + fr + m * 16)) * 4096 + col0;
#pragma unroll
                for (int bj = 0; bj < 2; ++bj) { *(f32x4*)(rowp + bj * HALF) = acc[0][bj][m][0]; *(f32x4*)(rowp + bj * HALF + 4) = acc[0][bj][m][1]; } }
        }
    }
};

template <class Epi, class Sched, bool ALIGN_EPI = false, bool SP2 = false>
__device__ __forceinline__ void gemm_phase(PG8_LAS unsigned char* lds, const Gemm g, const Sched& S, const Epi& E) {
    const int tid = threadIdx.x, wid = __builtin_amdgcn_readfirstlane(tid >> 6), lane = tid & 63, wr = wid >> 2, wc = wid & 3, fr = lane & 15, fq = lane >> 4;
    unsigned voffA[2], voffB[2];
#pragma unroll
    for (int i = 0; i < 2; ++i) { int R, C; stage_rc(tid * 16 + i * 8192, R, C); const int Rb = Epi::PERM ? ((R & ~31) + perm32(R & 31)) : R;
        voffA[i] = (unsigned)(R * g.lda + C) * 2u; voffB[i] = (unsigned)(Rb * g.ldb + C) * 2u; }
    const size_t kstep = (size_t)(BK * 2);
    const size_t hstepA = (size_t)HALF * g.lda * 2, hstepB = (size_t)HALF * g.ldb * 2;
    const size_t tstepA = 2 * hstepA, tstepB = 2 * hstepB;
    const unsigned ldsw = (unsigned)wid * 1024u;
    const int aoff = lds_byte(wr * 64 + fr, fq * 8), boff = lds_byte(wc * 32 + fr, fq * 8);
#define PG8_SA(b, h) (((b) * 2 + (h)) * HTB)
#define PG8_SB(b, h) ((4 + (b) * 2 + (h)) * HTB)
#define PG8_STAGE(bufoff, gbase, voff) do { _Pragma("unroll") for (int _i = 0; _i < 2; ++_i) \
        __builtin_amdgcn_global_load_lds((const unsigned*)((const char*)(gbase) + (voff)[_i]), (PG8_LAS unsigned*)(lds + (bufoff) + ldsw + _i * 8192), 16, 0, 0); } while (0)
#define PG8_LDA(dst, b, h) do { _Pragma("unroll") for (int m = 0; m < 4; ++m) _Pragma("unroll") for (int k = 0; k < 2; ++k) dst[m][k] = *(const PG8_LAS bf16x8*)(lds + PG8_SA(b, h) + aoff + m * 2048 + k * 1024); } while (0)
#define PG8_LDB(dst, b, h) do { _Pragma("unroll") for (int n = 0; n < 2; ++n) _Pragma("unroll") for (int k = 0; k < 2; ++k) dst[n][k] = *(const PG8_LAS bf16x8*)(lds + PG8_SB(b, h) + boff + n * 2048 + k * 1024); } while (0)
#define PG8_MMA(ai, bj, At, Bt) do { __builtin_amdgcn_s_setprio(1); _Pragma("unroll") for (int m = 0; m < 4; ++m) _Pragma("unroll") for (int n = 0; n < 2; ++n) _Pragma("unroll") for (int k = 0; k < 2; ++k) \
        acc[ai][bj][m][n] = __builtin_amdgcn_mfma_f32_16x16x32_bf16(Bt[n][k], At[m][k], acc[ai][bj][m][n], 0, 0, 0); __builtin_amdgcn_s_setprio(0); } while (0)
#define PG8_WAIT_V(n) asm volatile("s_waitcnt vmcnt(" #n ")" ::: "memory")
#define PG8_WAIT_L(n) asm volatile("s_waitcnt lgkmcnt(" #n ")" ::: "memory")
#define PG8_BAR __builtin_amdgcn_s_barrier()
#define PG8_SCHED __builtin_amdgcn_sched_barrier(0)
    Unit cur, nxt; int ui = 0;
    if (!S.next(0, cur)) return;
    f32x4 acc[2][2][4][2];
#pragma unroll
    for (int a = 0; a < 2; ++a)
#pragma unroll
        for (int b = 0; b < 2; ++b)
#pragma unroll
            for (int m = 0; m < 4; ++m)
#pragma unroll
                for (int n = 0; n < 2; ++n) acc[a][b][m][n] = (f32x4){0.f, 0.f, 0.f, 0.f};
    bf16x8 At[4][2], B0[2][2], B1[2][2];
    const char* cA = (const char*)g.A + (size_t)cur.pm * tstepA + (size_t)cur.pn * (size_t)g.a_pn_off * 2 + (size_t)cur.kb * kstep; const char* cB = (const char*)g.Bt + (size_t)cur.pn * tstepB + (size_t)cur.kb * kstep;
    S.a_ready(cur);
    if constexpr (SP2) {
        PG8_STAGE(PG8_SB(0, 0), cB, voffB); PG8_STAGE(PG8_SB(0, 1), cB + hstepB, voffB); PG8_STAGE(PG8_SA(0, 0), cA, voffA); PG8_STAGE(PG8_SA(0, 1), cA + hstepA, voffA);
        if (wr == 1) PG8_BAR;
        PG8_WAIT_V(2); PG8_BAR;
        PG8_STAGE(PG8_SB(1, 0), cB + kstep, voffB); PG8_STAGE(PG8_SA(1, 0), cA + kstep, voffA); PG8_STAGE(PG8_SB(1, 1), cB + hstepB + kstep, voffB);
        PG8_WAIT_V(6); PG8_BAR;
    } else {
        PG8_STAGE(PG8_SB(0, 0), cB, voffB); PG8_STAGE(PG8_SA(0, 0), cA, voffA); PG8_STAGE(PG8_SB(0, 1), cB + hstepB, voffB); PG8_STAGE(PG8_SA(0, 1), cA + hstepA, voffA);
        if (wr == 1) PG8_BAR;
        PG8_WAIT_V(4); PG8_BAR;
        PG8_STAGE(PG8_SB(1, 0), cB + kstep, voffB); PG8_STAGE(PG8_SA(1, 0), cA + kstep, voffA); PG8_STAGE(PG8_SB(1, 1), cB + hstepB + kstep, voffB);
        PG8_WAIT_V(6); PG8_BAR;
    }
    for (;;) {
        const bool has_next = S.next(ui + 1, nxt);
        const char* nA = has_next ? (const char*)g.A + (size_t)nxt.pm * tstepA + (size_t)nxt.pn * (size_t)g.a_pn_off * 2 + (size_t)nxt.kb * kstep : cA; const char* nB = has_next ? (const char*)g.Bt + (size_t)nxt.pn * tstepB + (size_t)nxt.kb * kstep : cB;
        const int nt = cur.nkt; const bool full = !cur.half;
        for (int t = 0; t < nt; t += 2) {
            const bool last = (t == nt - 2);
            const char* a1 = cA + (size_t)(t + 1) * kstep;
            const char* a2 = last ? nA : cA + (size_t)(t + 2) * kstep; const char* b2 = last ? nB : cB + (size_t)(t + 2) * kstep;
            const char* a3 = a2 + kstep; const char* b3 = b2 + kstep;
            if (last && has_next) S.a_ready(nxt);
            if constexpr (SP2) {
            const size_t hA = full ? hstepA : 0, hA2 = last ? ((has_next && !nxt.half) ? hstepA : 0) : hA;
            PG8_LDB(B0, 0, 0); PG8_LDB(B1, 0, 1); PG8_SCHED; PG8_LDA(At, 0, 0); PG8_STAGE(PG8_SA(1, 1), a1 + hA, voffA);
            PG8_WAIT_V(8); PG8_WAIT_L(0); PG8_BAR; PG8_MMA(0, 0, At, B0); PG8_MMA(0, 1, At, B1); PG8_BAR; PG8_SCHED;
            if (full) PG8_LDA(At, 0, 1); PG8_STAGE(PG8_SB(0, 0), b2, voffB); PG8_STAGE(PG8_SB(0, 1), b2 + hstepB, voffB); PG8_STAGE(PG8_SA(0, 0), a2, voffA);
            PG8_WAIT_V(8); PG8_WAIT_L(0); PG8_BAR; if (full) { PG8_MMA(1, 0, At, B0); PG8_MMA(1, 1, At, B1); } PG8_BAR; PG8_SCHED;
            PG8_LDB(B0, 1, 0); PG8_LDB(B1, 1, 1); PG8_SCHED; PG8_LDA(At, 1, 0); PG8_STAGE(PG8_SA(0, 1), a2 + hA2, voffA);
            PG8_WAIT_V(8); PG8_WAIT_L(0); PG8_BAR; PG8_MMA(0, 0, At, B0); PG8_MMA(0, 1, At, B1); PG8_BAR; PG8_SCHED;
            if (full) PG8_LDA(At, 1, 1); PG8_STAGE(PG8_SB(1, 0), b3, voffB); PG8_STAGE(PG8_SB(1, 1), b3 + hstepB, voffB); PG8_STAGE(PG8_SA(1, 0), a3, voffA);
            PG8_WAIT_V(8); PG8_WAIT_L(0); PG8_BAR; if (full) { PG8_MMA(1, 0, At, B0); PG8_MMA(1, 1, At, B1); } PG8_BAR; PG8_SCHED;
            } else {
            PG8_LDB(B0, 0, 0); PG8_SCHED; PG8_LDA(At, 0, 0); PG8_STAGE(PG8_SA(1, 1), a1 + hstepA, voffA);
            PG8_WAIT_L(8); PG8_BAR; PG8_WAIT_L(0); PG8_MMA(0, 0, At, B0); PG8_BAR; PG8_SCHED;
            PG8_LDB(B1, 0, 1); PG8_STAGE(PG8_SB(0, 0), b2, voffB);
            PG8_BAR; PG8_WAIT_L(0); PG8_MMA(0, 1, At, B1); PG8_BAR;
            PG8_LDA(At, 0, 1); PG8_STAGE(PG8_SA(0, 0), a2, voffA);
            PG8_BAR; PG8_WAIT_L(0); if (full) PG8_MMA(1, 0, At, B0); PG8_BAR; PG8_SCHED;
            PG8_STAGE(PG8_SB(0, 1), b2 + hstepB, voffB);
            PG8_WAIT_V(6); PG8_BAR; if (full) PG8_MMA(1, 1, At, B1); PG8_BAR;
            PG8_LDB(B0, 1, 0); PG8_SCHED; PG8_LDA(At, 1, 0); PG8_STAGE(PG8_SA(0, 1), a2 + hstepA, voffA);
            PG8_WAIT_L(8); PG8_BAR; PG8_WAIT_L(0); PG8_MMA(0, 0, At, B0); PG8_BAR; PG8_SCHED;
            PG8_LDB(B1, 1, 1); PG8_STAGE(PG8_SB(1, 0), b3, voffB);
            PG8_BAR; PG8_WAIT_L(0); PG8_MMA(0, 1, At, B1); PG8_BAR;
            PG8_LDA(At, 1, 1); PG8_STAGE(PG8_SA(1, 0), a3, voffA);
            PG8_BAR; PG8_WAIT_L(0); if (full) PG8_MMA(1, 0, At, B0); PG8_BAR; PG8_SCHED;
            PG8_STAGE(PG8_SB(1, 1), b3 + hstepB, voffB);
            PG8_WAIT_V(6); PG8_BAR; if (full) PG8_MMA(1, 1, At, B1); PG8_BAR;
            }
        }
        if constexpr (ALIGN_EPI) { if (wr == 0) PG8_BAR; }
        E(acc, cur, wr, wc, fr, fq); S.done(cur);
        if (!has_next) break;
#pragma unroll
        for (int a = 0; a < 2; ++a)
#pragma unroll
            for (int b = 0; b < 2; ++b)
#pragma unroll
                for (int m = 0; m < 4; ++m)
#pragma unroll
                    for (int n = 0; n < 2; ++n) acc[a][b][m][n] = (f32x4){0.f, 0.f, 0.f, 0.f};
        cur = nxt; cA = nA; cB = nB; ++ui;
        if constexpr (ALIGN_EPI) { if (wr == 1) PG8_BAR; }
    }
    PG8_WAIT_V(0);
    if constexpr (!ALIGN_EPI) { if (wr == 0) PG8_BAR; }
    PG8_BAR;
#undef PG8_SA
#undef PG8_SB
#undef PG8_STAGE
#undef PG8_LDA
#undef PG8_LDB
#undef PG8_MMA
#undef PG8_WAIT_V
#undef PG8_WAIT_L
#undef PG8_BAR
#undef PG8_SCHED
}
}

constexpr int NWAVES = 8;
constexpr int NPHASES = 12;
constexpr int D = 4096, TP = 8192, SEQ = 2048, NS = 128, MT = 8320, MP = 8448, NCOND = 132, NMOD = 24576;
constexpr int DIN = 10256, ZW = 10240, DPOOL = 1024, DKT = 1536, DVT = 3072, DKH = 384, DVH = 768, DFF = 11008;
constexpr int ZC_Q = 1024, ZC_K = 2560, ZC_V = 4096, ZC_G = 7168;
constexpr float EPS = 1e-6f;
constexpr float QSCALE = 0.05103103630798288f;
constexpr size_t OFF_POOLP = (size_t)MT * D, OFF_GLAP = OFF_POOLP + 61440, OFF_POOLS = OFF_GLAP + 4718592, OFF_GLAS = OFF_POOLS + 1966080;

constexpr size_t al256(size_t x) { return (x + 255) & ~(size_t)255; }
constexpr size_t WS_CTL = 0, CTL_REGION = 1u << 20, CTL_ZERO_BYTES = 40960;
constexpr size_t WS_MOD = CTL_REGION;
constexpr size_t WS_SC = WS_MOD + al256((size_t)NCOND * NMOD * 4);
constexpr size_t WS_WIN = WS_SC + al256((size_t)144 * D * 2);
constexpr size_t WS_WA = WS_WIN + al256((size_t)ZW * D * 2);
constexpr size_t WS_WOUT = WS_WA + al256((size_t)16 * D * 2);
constexpr size_t WS_W13 = WS_WOUT + al256((size_t)D * D * 2);
constexpr size_t WS_WFF2 = WS_W13 + al256((size_t)2 * DFF * D * 2);
constexpr size_t WS_WP = WS_WFF2 + al256((size_t)D * DFF * 2);
constexpr size_t WS_H = WS_WP + al256((size_t)1024 * 256 * 2);
constexpr size_t WS_Z = WS_H + al256((size_t)MP * D * 2);
constexpr size_t WS_QT = WS_Z + al256((size_t)MP * ZW * 2);
constexpr size_t WS_KT = WS_QT + al256((size_t)TP * DKT * 2);
constexpr size_t WS_EBL = WS_KT + al256((size_t)TP * DKT * 2);
constexpr size_t WS_LAS = WS_EBL + al256((size_t)256 * DKT * 4);
constexpr size_t WS_DP = WS_LAS + al256((size_t)128 * DKT * 4);
constexpr size_t WS_OB = WS_DP + al256((size_t)MP * DPOOL * 2);
constexpr size_t WS_MIX = WS_OB + al256((size_t)MT * DVT * 4);
constexpr size_t WS_X1 = WS_MIX + al256((size_t)MP * D * 2);
constexpr size_t WS_ACT = WS_X1 + al256((size_t)MT * D * 4);
constexpr size_t WS_ZS = WS_ACT + al256((size_t)MP * DFF * 2);
constexpr size_t WS_XS = WS_ZS + al256((size_t)4 * NS * ZW * 4);
constexpr int OV_KS = 8, OV_N = 22, OV_SPLIT = 43, OV_PA = 32, OV_PB = 64, OV_COLS = OV_N * 128;
constexpr size_t WS_SS = WS_XS + al256((size_t)16 * NS * D * 4);
constexpr size_t WS_END = WS_SS + al256((size_t)OV_KS * 2 * NS * OV_COLS * 4);
constexpr int CW_BAR = 4096, CW_Q = 8192;

constexpr int SCRATCH_BYTES = 151552;
constexpr int MISC_OFF = SCRATCH_BYTES;
constexpr int LDS_BYTES = SCRATCH_BYTES + 512;

#define GAS __attribute__((address_space(1)))
#define LAS __attribute__((address_space(3)))
typedef unsigned short bf16;
typedef unsigned v4u __attribute__((ext_vector_type(4)));
typedef unsigned v2u __attribute__((ext_vector_type(2)));
typedef float f32x4 __attribute__((ext_vector_type(4)));
typedef short bf16x8 __attribute__((ext_vector_type(8)));
#define LDS_WAIT() asm volatile("s_waitcnt lgkmcnt(0)" ::: "memory")
__device__ __forceinline__ unsigned f2bf(float f) { unsigned u = __builtin_bit_cast(unsigned, f); return (u + 0x7fffu + ((u >> 16) & 1u)) >> 16; }
__device__ __forceinline__ unsigned pk2(float lo, float hi) { return f2bf(lo) | (f2bf(hi) << 16); }
__device__ __forceinline__ float bflo(unsigned w) { return __builtin_bit_cast(float, w << 16); }
__device__ __forceinline__ float bfhi(unsigned w) { return __builtin_bit_cast(float, w & 0xffff0000u); }
__device__ __forceinline__ float bf2f(bf16 b) { return __builtin_bit_cast(float, ((unsigned)b) << 16); }
__device__ __forceinline__ float silu_acc(float x) { return x / (1.0f + __expf(-x)); }
__device__ __forceinline__ float wave_sum(float v) {
#pragma unroll
    for (int o = 1; o < 64; o <<= 1) v += __shfl_xor(v, o);
    return v;
}

__device__ __forceinline__ int lane_fresh() { int l; asm volatile("v_mbcnt_lo_u32_b32 %0, -1, 0\n\tv_mbcnt_hi_u32_b32 %0, -1, %0" : "=v"(l)); return l; }
#define XB_TMO      128
#define XB_XCNT(j)  (256  + 64 * (j))
#define XB_XSUB(j)  (1280 + 64 * (j))
#define XB_XGEN(j)  (2304 + 64 * (j))
#define XB_TOP      3328
#define XB_TOPGEN   3392
#define XCD_BAR_WORDS 3456
#define XB_SPIN_CAP (1u << 18)

__device__ __forceinline__ unsigned xb_ld(unsigned* p)              { return __hip_atomic_load(p, __ATOMIC_RELAXED, __HIP_MEMORY_SCOPE_AGENT); }
__device__ __forceinline__ unsigned xb_add(unsigned* p, unsigned v) { return __hip_atomic_fetch_add(p, v, __ATOMIC_RELAXED, __HIP_MEMORY_SCOPE_AGENT); }
__device__ __forceinline__ unsigned xb_xcc_id() { return (unsigned)__builtin_amdgcn_s_getreg((3 << 11) | 20) & 0xFu; }
#define XB_SPIN(cond, bar) do { unsigned _sp = 0; while (cond) { __builtin_amdgcn_s_sleep(1); \
    if ((++_sp & 255u) == 0u) { if (xb_ld(&(bar)[XB_TMO])) break; if (_sp > XB_SPIN_CAP) { atomicAdd(&(bar)[XB_TMO], 1u); break; } } } } while (0)

struct XcdBarrier {
    unsigned* bar; unsigned x;
    volatile LAS unsigned* st;
};
__device__ __forceinline__ XcdBarrier xcd_barrier_post(unsigned* bar, volatile LAS unsigned* st) {
    XcdBarrier b; b.bar = bar; b.x = xb_xcc_id(); b.st = st;
    if (threadIdx.x == 0) (void)xb_add(&bar[XB_XCNT(b.x)], 1u);
    return b;
}
__device__ __forceinline__ void xcd_barrier_complete(unsigned* bar, unsigned x, unsigned& nloc, unsigned& nx) {
    const unsigned G = gridDim.x * gridDim.y * gridDim.z;
    unsigned sum, cnt, mine, sp = 0u;
    for (;;) {
        sum = 0u; cnt = 0u; mine = 0u;
#pragma unroll
        for (unsigned j = 0; j < 16; ++j) { const unsigned c = xb_ld(&bar[XB_XCNT(j)]); sum += c; cnt += (c > 0u) ? 1u : 0u; mine = (j == x) ? c : mine; }
        if (sum == G) break;
        __builtin_amdgcn_s_sleep(1);
        if ((++sp & 255u) == 0u) { if (xb_ld(&bar[XB_TMO])) break; if (sp > XB_SPIN_CAP) { atomicAdd(&bar[XB_TMO], 1u); break; } }
    }
    nloc = mine > 0u ? mine : 1u; nx = cnt > 0u ? cnt : 1u;
}
__device__ __forceinline__ void xcd_barrier(const XcdBarrier& b) {
    asm volatile("s_waitcnt vmcnt(0)" ::: "memory");
    __syncthreads();
    if (threadIdx.x == 0) {
        unsigned* bar = b.bar;
        __builtin_amdgcn_s_waitcnt(0);
        unsigned nloc = b.st[0], nx = b.st[1];
        if (nloc == 0u) { xcd_barrier_complete(bar, b.x, nloc, nx); b.st[0] = nloc; b.st[1] = nx; }
        const unsigned old = xb_add(&bar[XB_XSUB(b.x)], 1u);
        const unsigned gen = old / nloc;
        if (old + 1u == (gen + 1u) * nloc) {
            __builtin_amdgcn_fence(__ATOMIC_RELEASE, "agent");
            asm volatile("s_waitcnt vmcnt(0)" ::: "memory");
            const unsigned og = xb_add(&bar[XB_TOP], 1u);
            const unsigned tg = og / nx;
            if (og + 1u == (tg + 1u) * nx) xb_add(&bar[XB_TOPGEN], 1u);
            else XB_SPIN(xb_ld(&bar[XB_TOPGEN]) == tg, bar);
            __builtin_amdgcn_fence(__ATOMIC_ACQUIRE, "agent");
            xb_add(&bar[XB_XGEN(b.x)], 1u);
            asm volatile("s_waitcnt vmcnt(0)" ::: "memory");
        } else {
            XB_SPIN(xb_ld(&bar[XB_XGEN(b.x)]) == gen, bar);
            __builtin_amdgcn_fence(__ATOMIC_ACQUIRE, "agent");
            asm volatile("s_waitcnt vmcnt(0)" ::: "memory");
        }
    }
    __syncthreads();
}

struct Ctx {
    const float *x_prompt, *x_sample, *state_pool, *state_gla, *c_prompt, *c_sample, *w_ada, *b_ada, *g_norm1, *w_in, *w_pool, *pool_scale, *w_a2, *b_a, *g_gla_out,
                *w_out, *g_norm2, *w_ff1, *w_ff3, *w_ff2, *g_final;
    float* out;
    float* MOD; bf16* SC; bf16 *WinT, *WaT, *WoutT, *W13T, *Wff2T, *WpT; bf16 *H, *Z, *QT, *KT; float *EBL, *LAS_; bf16* DP; bf16* OB; bf16* MIX; float* X1; bf16 *X1B, *OPB; bf16* ACT; float *ZS, *XS, *SS;
    LAS unsigned char* lds; int wave, G, gw, NGW;
};

__device__ __forceinline__ void tr_item(const float* W, int ldw, bf16* WT, int ldt, int k0, int n0, int drow0, LAS float* scr, int lane) {
    const int c4 = lane & 15, r4 = lane >> 4;
    const float* wp = W + (size_t)(k0 + r4) * ldw + n0 + 4 * c4;
#pragma unroll
    for (int hh = 0; hh < 2; ++hh) { f32x4 v[8];
#pragma unroll
        for (int i = 0; i < 8; ++i) { v[i] = *(const f32x4*)wp; wp += (size_t)4 * ldw; }
#pragma unroll
        for (int i = 0; i < 8; ++i) { LAS float* s = scr + (4 * (8 * hh + i) + r4) * 65 + 4 * c4; s[0] = v[i].x; s[1] = v[i].y; s[2] = v[i].z; s[3] = v[i].w; } }
    LDS_WAIT(); asm volatile("" ::: "memory");
    const int c = lane & 7;
#pragma unroll
    for (int j = 0; j < 8; ++j) { const int n = (lane >> 3) + 8 * j; const LAS float* s = scr + (8 * c) * 65 + n;
        v4u o; o.x = pk2(s[0 * 65], s[1 * 65]); o.y = pk2(s[2 * 65], s[3 * 65]); o.z = pk2(s[4 * 65], s[5 * 65]); o.w = pk2(s[6 * 65], s[7 * 65]);
        *(v4u*)(WT + (size_t)(drow0 + n) * ldt + k0 + 8 * c) = o; }
    LDS_WAIT(); asm volatile("" ::: "memory");
}
constexpr int I_IN = 64 * 160, I_OUT = 64 * 64, I_F1 = 64 * 172, I_F2 = 172 * 64, I_P = 64;
constexpr int N_TR_ITEMS = I_IN + I_OUT + 2 * I_F1 + I_F2 + I_P;
struct TrItem { const GAS float* W; GAS bf16* WT; int ldw, ldt, k0, n0, drow0; };
__device__ __forceinline__ TrItem tr_params(const Ctx& C, int it) {
    constexpr int B0 = I_IN, B1 = B0 + I_OUT, B2 = B1 + I_F1, B3 = B2 + I_F1, B4 = B3 + I_F2;
    const bool m0 = it < B0, m1 = !m0 && it < B1, m2 = it >= B1 && it < B2, m3 = it >= B2 && it < B3, m4 = it >= B3 && it < B4, m5 = it >= B4;
    int r = it - (m1 ? B0 : 0) - (m2 ? B1 : 0) - (m3 ? B2 : 0) - (m4 ? B3 : 0) - (m5 ? B4 : 0);
    const int g = m5 ? (r >> 4) : 0; r = m5 ? (r & 15) : r;
    const int nbd = (m0 ? 160 : 0) + ((m1 || m4) ? 64 : 0) + ((m2 || m3) ? 172 : 0) + (m5 ? 4 : 0);
    const int kb = r / nbd, nb = r - kb * nbd;
    typedef unsigned long long u64;
    const u64 wsel = ((u64)C.w_in & (u64)-(long long)m0) | ((u64)C.w_out & (u64)-(long long)m1) | ((u64)C.w_ff1 & (u64)-(long long)m2) | ((u64)C.w_ff3 & (u64)-(long long)m3) | ((u64)C.w_ff2 & (u64)-(long long)m4) | ((u64)C.w_pool & (u64)-(long long)m5);
    const u64 tsel = ((u64)C.WinT & (u64)-(long long)m0) | ((u64)C.WoutT & (u64)-(long long)m1) | ((u64)C.W13T & (u64)-(long long)(m2 || m3)) | ((u64)C.Wff2T & (u64)-(long long)m4) | ((u64)C.WpT & (u64)-(long long)m5);
    TrItem T;
    T.W = (const GAS float*)wsel + (size_t)g * 65536;
    T.WT = (GAS bf16*)tsel + (size_t)g * 65536;
    T.ldw = (m0 ? DIN : 0) + ((m1 || m4) ? D : 0) + ((m2 || m3) ? DFF : 0) + (m5 ? 256 : 0);
    T.ldt = m4 ? DFF : (m5 ? 256 : D);
    T.k0 = 64 * kb; T.n0 = 64 * nb;
    T.drow0 = (m2 || m3) ? ((T.n0 >> 7) * 256 + (T.n0 & 127) + (m3 ? 128 : 0)) : T.n0;
    return T;
}
__device__ __forceinline__ void tr_dispatch(const Ctx& C, int it, LAS float* scr, int lane) {
    const TrItem T = tr_params(C, it);
    tr_item((const float*)T.W, T.ldw, (bf16*)T.WT, T.ldt, T.k0, T.n0, T.drow0, scr, lane);
}
__device__ __forceinline__ void p0_small(const Ctx& C) {
    const int lane = lane_fresh();
    for (int i = C.gw * 64 + lane; i < 16 * D; i += C.NGW * 64) { const int r = i >> 12, k = i & 4095; C.WaT[i] = (bf16)f2bf(C.w_in[(size_t)k * DIN + ZW + r]); }
    for (int i = C.gw * 64 + lane; i < 144 * D; i += C.NGW * 64) { const int m = i >> 12, k = i & 4095; float v = 0.f;
        if (m < 4) v = silu_acc(C.c_prompt[m * D + k]); else if (m < NCOND) v = silu_acc(C.c_sample[(m - 4) * D + k]);
        C.SC[i] = (bf16)f2bf(v); }
}

struct __attribute__((packed, aligned(4))) F3 { float x, y, z; };
template <bool TR>
__device__ __forceinline__ void p1_kstep(const Ctx& C, f32x4 (&acc)[9][3], const __amdgpu_buffer_rsrc_t rB, const __amdgpu_buffer_rsrc_t rA, int& sB, int& sA, int tr_it, LAS float* scr) {
    const int lane = lane_fresh();
    const unsigned boff = (unsigned)((8 * (lane >> 4)) * NMOD + 3 * (lane & 15)) * 4u, aoff = (unsigned)((lane & 15) * D + 8 * (lane >> 4)) * 2u;
    typedef decltype(__builtin_amdgcn_raw_buffer_load_b96(rB, 0u, 0, 0)) ld3_t; typedef decltype(__builtin_amdgcn_raw_buffer_load_b128(rA, 0u, 0, 0)) ld4_t;
#define P1_F(u_) __uint_as_float((unsigned)(u_))
    const int c4 = lane & 15, r4 = lane >> 4;
    TrItem T; const GAS float* wp = nullptr; f32x4 tv[8];
    if constexpr (TR) { T = tr_params(C, tr_it); wp = T.W + (size_t)(T.k0 + r4) * T.ldw + T.n0 + 4 * c4;
#pragma unroll
        for (int i = 0; i < 8; ++i) { tv[i] = *(const GAS f32x4*)wp; wp += (size_t)4 * T.ldw; } }
    __builtin_amdgcn_sched_barrier(0);
    ld3_t RW[8]; ld4_t AF[9];
#pragma unroll
    for (int j = 0; j < 8; ++j) RW[j] = __builtin_amdgcn_raw_buffer_load_b96(rB, boff, sB + j * NMOD * 4, 0);
    sB += 32 * NMOD * 4;
    __builtin_amdgcn_sched_barrier(0);
    if constexpr (!TR) {
#pragma unroll
        for (int mt = 0; mt < 9; ++mt) AF[mt] = __builtin_amdgcn_raw_buffer_load_b128(rA, aoff, sA + 16 * mt * D * 2, 0);
    }
    if constexpr (TR) {
#pragma unroll
        for (int i = 0; i < 8; ++i) { LAS float* s = scr + (4 * i + r4) * 65 + 4 * c4; s[0] = tv[i].x; s[1] = tv[i].y; s[2] = tv[i].z; s[3] = tv[i].w; }
        __builtin_amdgcn_sched_barrier(0);
#pragma unroll
        for (int i = 0; i < 8; ++i) { tv[i] = *(const GAS f32x4*)wp; wp += (size_t)4 * T.ldw; }
        __builtin_amdgcn_sched_barrier(0);
#pragma unroll
        for (int i = 0; i < 8; ++i) { LAS float* s = scr + (4 * (8 + i) + r4) * 65 + 4 * c4; s[0] = tv[i].x; s[1] = tv[i].y; s[2] = tv[i].z; s[3] = tv[i].w; }
        __builtin_amdgcn_sched_barrier(0);
#pragma unroll
        for (int mt = 0; mt < 9; ++mt) AF[mt] = __builtin_amdgcn_raw_buffer_load_b128(rA, aoff, sA + 16 * mt * D * 2, 0);
        __builtin_amdgcn_sched_barrier(0);
        LDS_WAIT(); asm volatile("" ::: "memory");
        const int c = lane & 7;
#pragma unroll
        for (int j = 0; j < 8; ++j) { const int n = (lane >> 3) + 8 * j; const LAS float* s = scr + (8 * c) * 65 + n;
            v4u o; o.x = pg8::cvt_pk_bf16(s[0 * 65], s[1 * 65]); o.y = pg8::cvt_pk_bf16(s[2 * 65], s[3 * 65]); o.z = pg8::cvt_pk_bf16(s[4 * 65], s[5 * 65]); o.w = pg8::cvt_pk_bf16(s[6 * 65], s[7 * 65]);
            *(GAS v4u*)(T.WT + (size_t)(T.drow0 + n) * T.ldt + T.k0 + 8 * c) = o; }
        LDS_WAIT(); asm volatile("" ::: "memory");
    }
    sA += 64;
    v4u b0, b1, b2;
    b0.x = pg8::cvt_pk_bf16(P1_F(RW[0][0]), P1_F(RW[1][0])); b0.y = pg8::cvt_pk_bf16(P1_F(RW[2][0]), P1_F(RW[3][0])); b0.z = pg8::cvt_pk_bf16(P1_F(RW[4][0]), P1_F(RW[5][0])); b0.w = pg8::cvt_pk_bf16(P1_F(RW[6][0]), P1_F(RW[7][0]));
    b1.x = pg8::cvt_pk_bf16(P1_F(RW[0][1]), P1_F(RW[1][1])); b1.y = pg8::cvt_pk_bf16(P1_F(RW[2][1]), P1_F(RW[3][1])); b1.z = pg8::cvt_pk_bf16(P1_F(RW[4][1]), P1_F(RW[5][1])); b1.w = pg8::cvt_pk_bf16(P1_F(RW[6][1]), P1_F(RW[7][1]));
    b2.x = pg8::cvt_pk_bf16(P1_F(RW[0][2]), P1_F(RW[1][2])); b2.y = pg8::cvt_pk_bf16(P1_F(RW[2][2]), P1_F(RW[3][2])); b2.z = pg8::cvt_pk_bf16(P1_F(RW[4][2]), P1_F(RW[5][2])); b2.w = pg8::cvt_pk_bf16(P1_F(RW[6][2]), P1_F(RW[7][2]));
    const bf16x8 B0 = __builtin_bit_cast(bf16x8, b0), B1 = __builtin_bit_cast(bf16x8, b1), B2 = __builtin_bit_cast(bf16x8, b2);
#pragma unroll
    for (int mt = 0; mt < 9; ++mt) { const bf16x8 a_ = __builtin_bit_cast(bf16x8, AF[mt]);
        acc[mt][0] = __builtin_amdgcn_mfma_f32_16x16x32_bf16(a_, B0, acc[mt][0], 0, 0, 0);
        acc[mt][1] = __builtin_amdgcn_mfma_f32_16x16x32_bf16(a_, B1, acc[mt][1], 0, 0, 0);
        acc[mt][2] = __builtin_amdgcn_mfma_f32_16x16x32_bf16(a_, B2, acc[mt][2], 0, 0, 0); }
#undef P1_F
}
__device__ __forceinline__ void p1_adaln(const Ctx& C) {
    const int w = C.wave, sub = w & 1, kq = w >> 1;
    LAS f32x4* slab = (LAS f32x4*)C.lds;
    LAS float* scr = (LAS float*)(C.lds + w * 16640);
    int tr_it = C.gw;
    const __amdgpu_buffer_rsrc_t rB = __builtin_amdgcn_make_buffer_rsrc((void*)C.w_ada, 0, (int)((size_t)D * NMOD * 4), 0x00020000);
    const __amdgpu_buffer_rsrc_t rA = __builtin_amdgcn_make_buffer_rsrc((void*)C.SC, 0, 144 * D * 2, 0x00020000);
    for (int cg = blockIdx.x; cg < 256; cg += C.G) {
        const int n0 = 96 * cg + 48 * sub, kbase = 1024 * kq;
        f32x4 acc[9][3];
#pragma unroll
        for (int mt = 0; mt < 9; ++mt)
#pragma unroll
            for (int i = 0; i < 3; ++i) acc[mt][i] = (f32x4){0.f, 0.f, 0.f, 0.f};
        int sB = (kbase * NMOD + n0) * 4, sA = kbase * 2;
        int ks = 0;
#pragma unroll 1
        for (; ks < 32 && tr_it < N_TR_ITEMS; ++ks) { p1_kstep<true>(C, acc, rB, rA, sB, sA, tr_it, scr); tr_it += C.NGW; }
#pragma unroll 1
        for (; ks < 32; ++ks) p1_kstep<false>(C, acc, rB, rA, sB, sA, 0, scr);
        __syncthreads();
        { const int lane = lane_fresh(), c = lane & 15, g = lane >> 4;
        if (w >= 4) {
#pragma unroll
            for (int q = 0; q < 27; ++q) slab[(w - 4) * 27 * 64 + q * 64 + lane] = acc[q / 3][q % 3];
        }
        __syncthreads();
        if (w < 4) {
#pragma unroll
            for (int q = 0; q < 27; ++q) { acc[q / 3][q % 3] += slab[w * 27 * 64 + q * 64 + lane]; if ((q % 3) == 2) asm volatile("" ::: "memory"); }
            if (w >= 2) {
#pragma unroll
                for (int q = 0; q < 27; ++q) slab[w * 27 * 64 + q * 64 + lane] = acc[q / 3][q % 3];
            }
        }
        __syncthreads();
        if (w < 2) {
#pragma unroll
            for (int q = 0; q < 27; ++q) { acc[q / 3][q % 3] += slab[(w + 2) * 27 * 64 + q * 64 + lane]; if ((q % 3) == 2) asm volatile("" ::: "memory"); }
            const float bb0 = C.b_ada[n0 + 3 * c], bb1 = C.b_ada[n0 + 3 * c + 1], bb2 = C.b_ada[n0 + 3 * c + 2];
            int g2 = g; asm volatile("" : "+v"(g2));
            GAS float* o = (GAS float*)C.MOD + (size_t)(4 * g2) * NMOD + n0 + 3 * c;
#pragma unroll
            for (int mt = 0; mt < 9; ++mt) {
#pragma unroll
                for (int r = 0; r < 4; ++r) { const int m = 16 * mt + 4 * g2 + r;
                    if (m < NCOND) { o[0] = acc[mt][0][r] + bb0; o[1] = acc[mt][1][r] + bb1; o[2] = acc[mt][2][r] + bb2; }
                    o += NMOD; asm volatile("" : "+v"(o)); }
                o += 12 * NMOD; }
        }
        }
        __syncthreads();
    }
    for (; tr_it < N_TR_ITEMS; tr_it += C.NGW) tr_dispatch(C, tr_it, scr, lane_fresh());
}

template <int NSL>
__device__ __forceinline__ void sample_row_from_slabs(const float* base, const float* gate, const float* slabs, int n, f32x4 (&v)[2], float& ssq, LAS float* lds_red, int t, int w) {
#pragma unroll
    for (int j = 0; j < 2; ++j) { const int c = 4 * t + 2048 * j;
        f32x4 a = *(const f32x4*)(slabs + ((size_t)0 * NS + n) * D + c);
#pragma unroll
        for (int k = 1; k < NSL; ++k) a += *(const f32x4*)(slabs + ((size_t)k * NS + n) * D + c);
        v[j] = *(const f32x4*)(base + c) + *(const f32x4*)(gate + c) * a; }
    float s = (v[0].x * v[0].x + v[0].y * v[0].y) + (v[0].z * v[0].z + v[0].w * v[0].w) + (v[1].x * v[1].x + v[1].y * v[1].y) + (v[1].z * v[1].z + v[1].w * v[1].w);
    s = wave_sum(s);
    __syncthreads();
    if ((t & 63) == 0) lds_red[w] = s;
    __syncthreads();
    ssq = 0.f;
#pragma unroll
    for (int ww = 0; ww < 8; ++ww) ssq += lds_red[ww];
}

template <bool X16>
__device__ __forceinline__ void norm_rows(const Ctx& C, const float* xa, const bf16* xa16, const float* xb, const float* gain, int sh_off, int sc_off, bf16* Hout, const float* slabs, int gate_off, float* x1s) {
    const int lane = lane_fresh();
    auto do_row = [&](int row) {
        v2u* o = (v2u*)(Hout + (size_t)row * D) + lane;
        if (row >= MT) {
#pragma unroll
            for (int j = 0; j < 16; ++j) o[64 * j] = (v2u){0u, 0u};
            return;
        }
        if (slabs != nullptr && row >= TP) return;
        if (X16 && row < TP) {
            const v4u* xv = (const v4u*)(xa16 + (size_t)row * D) + lane;
            v4u w[8]; float s = 0.f;
#pragma unroll
            for (int j = 0; j < 8; ++j) w[j] = xv[64 * j];
#pragma unroll
            for (int j = 0; j < 8; ++j) { const float a0 = bflo(w[j].x), a1 = bfhi(w[j].x), a2 = bflo(w[j].y), a3 = bfhi(w[j].y), a4 = bflo(w[j].z), a5 = bfhi(w[j].z), a6 = bflo(w[j].w), a7 = bfhi(w[j].w);
                s += ((a0 * a0 + a1 * a1) + (a2 * a2 + a3 * a3)) + ((a4 * a4 + a5 * a5) + (a6 * a6 + a7 * a7)); }
            const float rstd = 1.0f / sqrtf(wave_sum(s) * (1.0f / D) + EPS);
            const float* md = C.MOD + (size_t)(row >> 11) * NMOD;
            v4u* ob = (v4u*)(Hout + (size_t)row * D) + lane;
#pragma unroll
            for (int j = 0; j < 8; ++j) { const int c = 8 * (64 * j + lane);
                const f32x4 g0 = *(const f32x4*)(gain + c), g1 = *(const f32x4*)(gain + c + 4), sh0 = *(const f32x4*)(md + sh_off + c), sh1 = *(const f32x4*)(md + sh_off + c + 4);
                const f32x4 sc0 = *(const f32x4*)(md + sc_off + c), sc1 = *(const f32x4*)(md + sc_off + c + 4);
                const f32x4 x0 = (f32x4){bflo(w[j].x), bfhi(w[j].x), bflo(w[j].y), bfhi(w[j].y)}, x1 = (f32x4){bflo(w[j].z), bfhi(w[j].z), bflo(w[j].w), bfhi(w[j].w)};
                const f32x4 h0 = x0 * rstd * g0 * (sc0 + 1.0f) + sh0, h1 = x1 * rstd * g1 * (sc1 + 1.0f) + sh1;
                ob[64 * j] = (v4u){pk2(h0.x, h0.y), pk2(h0.z, h0.w), pk2(h1.x, h1.y), pk2(h1.z, h1.w)}; }
            return;
        }
        const float* xr = row < TP ? xa + (size_t)row * D : xb + (size_t)(row - TP) * D;
        const int ci = row < TP ? (row >> 11) : (4 + row - TP);
        const f32x4* xv = (const f32x4*)xr + lane;
        f32x4 v[16]; float s = 0.f;
#pragma unroll
        for (int j = 0; j < 16; ++j) { v[j] = xv[64 * j]; s += (v[j].x * v[j].x + v[j].y * v[j].y) + (v[j].z * v[j].z + v[j].w * v[j].w); }
        const float rstd = 1.0f / sqrtf(wave_sum(s) * (1.0f / D) + EPS);
        const f32x4* gv = (const f32x4*)gain + lane;
        const f32x4* shv = (const f32x4*)(C.MOD + (size_t)ci * NMOD + sh_off) + lane;
        const f32x4* scv = (const f32x4*)(C.MOD + (size_t)ci * NMOD + sc_off) + lane;
#pragma unroll
        for (int j = 0; j < 16; ++j) { const f32x4 gg = gv[64 * j], sh = shv[64 * j], sc = scv[64 * j];
            const f32x4 h = v[j] * rstd * gg * (sc + 1.0f) + sh;
            o[64 * j] = (v2u){pk2(h.x, h.y), pk2(h.z, h.w)}; }
    };
    for (int bi = (int)blockIdx.x; bi < TP / 32; bi += C.G)
#pragma unroll 1
        for (int k = 0; k < 4; ++k) do_row(32 * bi + C.wave + 8 * k);
    for (int n = (int)blockIdx.x; n < MP - TP; n += C.G) if (C.wave == (n & 7)) do_row(TP + n);
    if (slabs != nullptr) {
        const int t = threadIdx.x, w = C.wave;
        for (int n = blockIdx.x; n < NS; n += C.G) {
            const int row = TP + n; const float* md = C.MOD + (size_t)(4 + n) * NMOD;
            f32x4 v[2]; float ssq;
            sample_row_from_slabs<8>(xb + (size_t)n * D, md + gate_off, slabs, n, v, ssq, (LAS float*)C.lds, t, w);
            const float rstd = 1.0f / sqrtf(ssq * (1.0f / D) + EPS);
#pragma unroll
            for (int j = 0; j < 2; ++j) { const int c = 4 * t + 2048 * j;
                *(f32x4*)(x1s + (size_t)row * D + c) = v[j];
                const f32x4 gg = *(const f32x4*)(gain + c), sh = *(const f32x4*)(md + sh_off + c), sc = *(const f32x4*)(md + sc_off + c);
                const f32x4 h = v[j] * rstd * gg * (sc + 1.0f) + sh;
                *(v2u*)(Hout + (size_t)row * D + c) = (v2u){pk2(h.x, h.y), pk2(h.z, h.w)}; }
        }
    }
}

__device__ __forceinline__ float log_sigmoid_f(float x) { return fminf(x, 0.f) - __logf(1.0f + __expf(-fabsf(x))); }
template <int W>
__device__ __forceinline__ void pool_rows32(const Ctx& C, int row0, int t0, int t) {
    const char* zb = (const char*)C.Z + (size_t)row0 * ZW * 2;
    char* db = (char*)C.DP + (size_t)row0 * DPOOL * 2;
    const unsigned vo = 4u * (unsigned)t;
    unsigned u[W - 1 + 32];
#pragma unroll
    for (int k = 0; k < W - 1; ++k) { const int r = t0 - (W - 1) + k; u[k] = (r >= 0) ? *(const unsigned*)(zb - (ptrdiff_t)(W - 1 - k) * ZW * 2 + vo) : 0u; }
#pragma unroll
    for (int i = 0; i < 32; ++i) u[W - 1 + i] = *(const unsigned*)(zb + (size_t)i * ZW * 2 + vo);
    float s0 = 0.f, s1 = 0.f;
#pragma unroll
    for (int k = 0; k < W - 1; ++k) { s0 += bflo(u[k]); s1 += bfhi(u[k]); }
    const bool tail = (t0 + 32 == SEQ);
#pragma unroll
    for (int i = 0; i < 32; ++i) { const unsigned cur = u[W - 1 + i]; const float u0 = bflo(cur), u1 = bfhi(cur);
        s0 += u0; s1 += u1;
        if (i > 0) { s0 -= bflo(u[i - 1]); s1 -= bfhi(u[i - 1]); }
        const int pos = t0 + i; const float inv = 1.0f / (float)(pos + 1 < W ? pos + 1 : W);
        *(unsigned*)(db + (size_t)i * DPOOL * 2 + vo) = pk2(s0 * inv - u0, s1 * inv - u1);
        if (i >= 17 && tail) { float* o = (float*)((char*)(C.out + OFF_POOLP + ((size_t)(row0 / SEQ) * 15 + (i - 17)) * DPOOL) + 2u * vo); o[0] = u0; o[1] = u1; } }
}
__device__ __forceinline__ void p4_prep(const Ctx& C) {
    const int t = threadIdx.x, lane = lane_fresh(), w = C.wave;
    LAS float* part = (LAS float*)C.lds;
    LAS float* alr = (LAS float*)(C.lds + 16384);
    LAS float* sred = (LAS float*)(C.lds + 16384 + 2048);
    LAS float* salr = sred + 128;
    for (int i = blockIdx.x * 512 + t; i < NS * ZW / 4; i += C.G * 512) { const int n = i / (ZW / 4), c4 = i % (ZW / 4);
        f32x4 a = *(const f32x4*)(C.ZS + ((size_t)0 * NS + n) * ZW + 4 * c4);
#pragma unroll
        for (int k = 1; k < 4; ++k) a += *(const f32x4*)(C.ZS + ((size_t)k * NS + n) * ZW + 4 * c4);
        *(v2u*)(C.Z + (size_t)(TP + n) * ZW + 4 * c4) = (v2u){pk2(a.x, a.y), pk2(a.z, a.w)}; }
    for (int ch = blockIdx.x; ch < TP / 32; ch += C.G) {
        const int row0 = 32 * ch;
        {
            const int r = lane & 15, g = lane >> 4;
            f32x4 pa[2] = {(f32x4){0.f, 0.f, 0.f, 0.f}, (f32x4){0.f, 0.f, 0.f, 0.f}};
#pragma unroll 8
            for (int ks = 0; ks < 16; ++ks) { const int k = 512 * w + 32 * ks + 8 * g;
                const bf16x8 bw = *(const bf16x8*)(C.WaT + (size_t)r * D + k);
#pragma unroll
                for (int mt = 0; mt < 2; ++mt) { const bf16x8 a = *(const bf16x8*)(C.H + (size_t)(row0 + 16 * mt + r) * D + k);
                    pa[mt] = __builtin_amdgcn_mfma_f32_16x16x32_bf16(a, bw, pa[mt], 0, 0, 0); } }
#pragma unroll
            for (int mt = 0; mt < 2; ++mt)
#pragma unroll
                for (int q = 0; q < 4; ++q) part[w * 512 + (16 * mt + 4 * g + q) * 16 + r] = pa[mt][q];
        }
        __syncthreads();
        { float sm = 0.f;
#pragma unroll
            for (int ww = 0; ww < 8; ++ww) sm += part[ww * 512 + t];
            alr[t] = sm; }
        __syncthreads();
#pragma unroll 1
        for (int cc = 0; cc < 3; ++cc) { const int c = t + 512 * cc; const unsigned vq = 2u * (unsigned)(ZC_Q + c), vk = 2u * (unsigned)(ZC_K + c), vc = 2u * (unsigned)c;
            float w2[16]; const float ba = C.b_a[c];
#pragma unroll
            for (int r = 0; r < 16; ++r) w2[r] = C.w_a2[r * DKT + c];
            float bc = 0.f;
#pragma unroll 1
            for (int hh = 0; hh < 2; ++hh) {
                const char* zb = (const char*)C.Z + (size_t)(row0 + 16 * hh) * ZW * 2;
                char* qb = (char*)C.QT + (size_t)(row0 + 16 * hh) * DKT * 2; char* kb = (char*)C.KT + (size_t)(row0 + 16 * hh) * DKT * 2;
                bf16 qv[16], kv[16];
#pragma unroll
                for (int i = 0; i < 16; ++i) { qv[i] = *(const bf16*)(zb + (size_t)i * ZW * 2 + vq); kv[i] = *(const bf16*)(zb + (size_t)i * ZW * 2 + vk); }
#pragma unroll
                for (int i = 0; i < 16; ++i) {
                    float x = ba;
#pragma unroll
                    for (int q = 0; q < 4; ++q) { const f32x4 av = *(const LAS f32x4*)(alr + (16 * hh + i) * 16 + 4 * q);
                        x = fmaf(av.x, w2[4 * q], x); x = fmaf(av.y, w2[4 * q + 1], x); x = fmaf(av.z, w2[4 * q + 2], x); x = fmaf(av.w, w2[4 * q + 3], x); }
                    bc += log_sigmoid_f(x) * (1.0f / 16.0f);
                    *(bf16*)(qb + (size_t)i * DKT * 2 + vc) = (bf16)f2bf(bf2f(qv[i]) * QSCALE * __expf(bc));
                    *(bf16*)(kb + (size_t)i * DKT * 2 + vc) = (bf16)f2bf(bf2f(kv[i]) * __expf(-bc));
                }
            }
            C.EBL[(size_t)ch * DKT + c] = __expf(bc);
        }
        { const int t0 = row0 & (SEQ - 1);
            switch (w >> 1) { case 0: pool_rows32<2>(C, row0, t0, t); break; case 1: pool_rows32<4>(C, row0, t0, t); break;
                              case 2: pool_rows32<8>(C, row0, t0, t); break; default: pool_rows32<16>(C, row0, t0, t); break; } }
        __syncthreads();
    }
    for (int n = blockIdx.x; n < NS; n += C.G) {
        const int row = TP + n;
        {
            const v4u hv = *(const v4u*)(C.H + (size_t)row * D + 8 * t);
            const float hf[8] = {bflo(hv.x), bfhi(hv.x), bflo(hv.y), bfhi(hv.y), bflo(hv.z), bfhi(hv.z), bflo(hv.w), bfhi(hv.w)};
#pragma unroll
            for (int r = 0; r < 16; ++r) { const v4u wv = *(const v4u*)(C.WaT + (size_t)r * D + 8 * t);
                float p = hf[0] * bflo(wv.x) + hf[1] * bfhi(wv.x) + hf[2] * bflo(wv.y) + hf[3] * bfhi(wv.y) + hf[4] * bflo(wv.z) + hf[5] * bfhi(wv.z) + hf[6] * bflo(wv.w) + hf[7] * bfhi(wv.w);
                p = wave_sum(p);
                if (lane == 0) sred[w * 16 + r] = p; }
        }
        __syncthreads();
        if (t < 16) { float sm = 0.f;
#pragma unroll
            for (int ww = 0; ww < 8; ++ww) sm += sred[ww * 16 + t];
            salr[t] = sm; }
        __syncthreads();
        float a[16];
#pragma unroll
        for (int q = 0; q < 4; ++q) { const f32x4 av = *(const LAS f32x4*)(salr + 4 * q); a[4 * q] = av.x; a[4 * q + 1] = av.y; a[4 * q + 2] = av.z; a[4 * q + 3] = av.w; }
#pragma unroll
        for (int cc = 0; cc < 3; ++cc) { const int c = t + 512 * cc; float x = C.b_a[c];
#pragma unroll
            for (int r = 0; r < 16; ++r) x = fmaf(a[r], C.w_a2[r * DKT + c], x);
            C.LAS_[(size_t)n * DKT + c] = log_sigmoid_f(x) * (1.0f / 16.0f); }
        __syncthreads();
    }
}

__device__ __forceinline__ void p5_sample_pool(const Ctx& C) {
    const int t = threadIdx.x, w = C.wave;
    for (int n = blockIdx.x; n < NS; n += C.G) {
        const int row = TP + n;
        {
            const int wdw = 2 << (w >> 1); const float inv = 1.0f / (float)wdw;
            const unsigned uu = ((const unsigned*)C.Z)[(size_t)row * (ZW / 2) + t]; const float u0 = bflo(uu), u1 = bfhi(uu);
            const float* sp = C.state_pool + (size_t)n * 15 * DPOOL + 2 * t;
            float* so = C.out + OFF_POOLS + (size_t)n * 15 * DPOOL + 2 * t;
            float s0 = u0, s1 = u1;
#pragma unroll
            for (int r = 0; r < 15; ++r) { const float p0 = sp[(size_t)r * DPOOL], p1 = sp[(size_t)r * DPOOL + 1];
                if (r >= 16 - wdw) { s0 += p0; s1 += p1; }
                if (r >= 1) { so[(size_t)(r - 1) * DPOOL] = p0; so[(size_t)(r - 1) * DPOOL + 1] = p1; } }
            so[(size_t)14 * DPOOL] = u0; so[(size_t)14 * DPOOL + 1] = u1;
            ((unsigned*)C.DP)[(size_t)row * (DPOOL / 2) + t] = pk2(s0 * inv - u0, s1 * inv - u1);
        }
    }
}

__device__ __forceinline__ void p5_gla_sample_q(const Ctx& C, unsigned* qctr) {
    const int t = threadIdx.x, lane = lane_fresh(), w = C.wave;
    LAS float* qs = (LAS float*)C.lds; LAS float* ks = qs + 384; LAS float* as = ks + 384;
    LAS float* opart = (LAS float*)(C.lds + 8192);
    volatile LAS unsigned* itw = (volatile LAS unsigned*)(C.lds + 8192 + 8192);
    if (t == 0) itw[0] = atomicAdd(qctr, 1u);
    __syncthreads();
    for (int par = 0;; par ^= 1) {
        const int it = (int)itw[par];
        if (it >= NS * 12) break;
        if (t == 0) itw[par ^ 1] = atomicAdd(qctr, 1u);
        const int n = it / 12, r12 = it % 12, h = r12 / 3, et = r12 % 3, row = TP + n;
        if (t < DKH) { qs[t] = bf2f(C.Z[(size_t)row * ZW + ZC_Q + h * DKH + t]) * QSCALE; ks[t] = bf2f(C.Z[(size_t)row * ZW + ZC_K + h * DKH + t]);
            as[t] = __expf(C.LAS_[(size_t)n * DKT + h * DKH + t]); }
        const v2u vv = *(const v2u*)(C.Z + (size_t)row * ZW + ZC_V + h * DVH + 256 * et + 4 * lane);
        const f32x4 v = (f32x4){bflo(vv.x), bfhi(vv.x), bflo(vv.y), bfhi(vv.y)};
        f32x4 o = (f32x4){0.f, 0.f, 0.f, 0.f};
        const float* S0 = C.state_gla + ((size_t)(n * 4 + h) * DKH + w) * DVH + 256 * et + 4 * lane;
        float* S1 = C.out + OFF_GLAS + ((size_t)(n * 4 + h) * DKH + w) * DVH + 256 * et + 4 * lane;
        f32x4 ra[16], rb[16];
#pragma unroll
        for (int i = 0; i < 16; ++i) ra[i] = __builtin_nontemporal_load((const f32x4*)(S0 + (size_t)(8 * i) * DVH));
#pragma unroll
        for (int i = 0; i < 16; ++i) rb[i] = __builtin_nontemporal_load((const f32x4*)(S0 + (size_t)(8 * (16 + i)) * DVH));
        __syncthreads();
#pragma unroll
        for (int i = 0; i < 16; ++i) { const int d = w + 8 * i; const f32x4 sn = ra[i] * as[d] + v * ks[d];
            __builtin_nontemporal_store(sn, (f32x4*)(S1 + (size_t)(8 * i) * DVH)); o += sn * qs[d]; }
#pragma unroll
        for (int i = 0; i < 16; ++i) ra[i] = __builtin_nontemporal_load((const f32x4*)(S0 + (size_t)(8 * (32 + i)) * DVH));
#pragma unroll
        for (int i = 0; i < 16; ++i) { const int d = w + 8 * (16 + i); const f32x4 sn = rb[i] * as[d] + v * ks[d];
            __builtin_nontemporal_store(sn, (f32x4*)(S1 + (size_t)(8 * (16 + i)) * DVH)); o += sn * qs[d]; }
#pragma unroll
        for (int i = 0; i < 16; ++i) { const int d = w + 8 * (32 + i); const f32x4 sn = ra[i] * as[d] + v * ks[d];
            __builtin_nontemporal_store(sn, (f32x4*)(S1 + (size_t)(8 * (32 + i)) * DVH)); o += sn * qs[d]; }
        *(LAS f32x4*)(opart + w * 256 + 4 * lane) = o;
        __syncthreads();
        if (t < 256) { float sum = 0.f;
#pragma unroll
            for (int ww = 0; ww < 8; ++ww) sum += opart[ww * 256 + t];
            C.OB[(size_t)row * DVT + h * DVH + 256 * et + t] = (bf16)f2bf(sum); }
        __syncthreads();
    }
}

constexpr int GL_QL = 0, GL_KL = 24576, GL_KT = 49152, GL_VT = 76800, GL_P = 81408, GL_OS = 83712;
__device__ __forceinline__ bf16x8 mk_frag(v2u lo, v2u hi) { v4u x; x.x = lo.x; x.y = lo.y; x.z = hi.x; x.w = hi.y; return __builtin_bit_cast(bf16x8, x); }
__device__ __forceinline__ void p5_gla_prompt(const Ctx& C) {
    const int t = threadIdx.x, lane = lane_fresh(), w = C.wave, c = lane & 15, g = lane >> 4, dg = w >> 1, eh = w & 1;
    LAS unsigned char* L = C.lds;
    for (int item = blockIdx.x; item < 192; item += C.G) {
        const int bh = 2 * (item & 7) + ((item >> 3) / 12), es = (item >> 3) % 12, h = bh & 3, b = bh >> 2;
        const bf16* qg = C.QT + (size_t)(b * SEQ) * DKT + h * DKH;
        const bf16* kg = C.KT + (size_t)(b * SEQ) * DKT + h * DKH;
        const bf16* vg = C.Z + (size_t)(b * SEQ) * ZW + ZC_V + h * DVH + 64 * es;
        const int q_row[3] = {t / 48, (t + 512) / 48, (t + 1024) / 48}, q_ch[3] = {t % 48, (t + 512) % 48, (t + 1024) % 48};
        const int k_rp = t & 15, k_ch0 = t >> 4, k_ch1 = (t >> 4) + 32;
        const int v_rp = t & 15, v_ch = t >> 4;
        f32x4 R[3][2][2];
#pragma unroll
        for (int p = 0; p < 3; ++p)
#pragma unroll
            for (int hf = 0; hf < 2; ++hf)
#pragma unroll
                for (int et = 0; et < 2; ++et) R[p][hf][et] = (f32x4){0.f, 0.f, 0.f, 0.f};
        if (t < 128) { const int i = t >> 3, q = t & 7; *(LAS unsigned*)(L + GL_P + i * 72 + 32 + 4 * q) = 0u; }
        v4u pq[3], pk[4], pv[2];
        const unsigned qo0 = (unsigned)(q_row[0] * DKT + 8 * q_ch[0]) * 2u, qo1 = (unsigned)(q_row[1] * DKT + 8 * q_ch[1]) * 2u, qo2 = (unsigned)(q_row[2] * DKT + 8 * q_ch[2]) * 2u;
        const unsigned ko0 = (unsigned)(2 * k_rp * DKT + 8 * k_ch0) * 2u, ko1 = (unsigned)(2 * k_rp * DKT + 8 * (t < 256 ? k_ch1 : k_ch0)) * 2u, vo0 = (unsigned)(2 * v_rp * ZW + 8 * (t < 128 ? v_ch : 0)) * 2u;
#define GLA_PREFETCH(s_) do { const char* qb_ = (const char*)qg + (size_t)(s_) * 32 * DKT * 2; const char* kb_ = (const char*)kg + (size_t)(s_) * 32 * DKT * 2; const char* vb_ = (const char*)vg + (size_t)(s_) * 32 * ZW * 2; \
            pq[0] = *(const v4u*)(qb_ + qo0); pq[1] = *(const v4u*)(qb_ + qo1); pq[2] = *(const v4u*)(qb_ + qo2); \
            pk[0] = *(const v4u*)(kb_ + ko0); pk[1] = *(const v4u*)(kb_ + ko0 + DKT * 2); \
            pk[2] = *(const v4u*)(kb_ + ko1); pk[3] = *(const v4u*)(kb_ + ko1 + DKT * 2); \
            pv[0] = *(const v4u*)(vb_ + vo0); pv[1] = *(const v4u*)(vb_ + vo0 + ZW * 2); } while (0)
        GLA_PREFETCH(0);
#pragma unroll 1
        for (int s = 0; s < 64; ++s) {
#pragma unroll
            for (int q = 0; q < 3; ++q) *(LAS v4u*)(L + GL_QL + q_row[q] * 768 + 16 * (q_ch[q] ^ (q_row[q] & 15))) = pq[q];
            {
                const int r0 = 2 * k_rp, r1 = 2 * k_rp + 1;
                *(LAS v4u*)(L + GL_KL + r0 * 768 + 16 * (k_ch0 ^ (r0 & 15))) = pk[0];
                *(LAS v4u*)(L + GL_KL + r1 * 768 + 16 * (k_ch0 ^ (r1 & 15))) = pk[1];
                const unsigned a0[4] = {pk[0].x, pk[0].y, pk[0].z, pk[0].w}, a1[4] = {pk[1].x, pk[1].y, pk[1].z, pk[1].w};
#pragma unroll
                for (int jj = 0; jj < 4; ++jj) {
                    *(LAS unsigned*)(L + GL_KT + (8 * k_ch0 + 2 * jj) * 72 + 4 * k_rp) = (a0[jj] & 0xffffu) | (a1[jj] << 16);
                    *(LAS unsigned*)(L + GL_KT + (8 * k_ch0 + 2 * jj + 1) * 72 + 4 * k_rp) = (a0[jj] >> 16) | (a1[jj] & 0xffff0000u); }
                if (t < 256) {
                    *(LAS v4u*)(L + GL_KL + r0 * 768 + 16 * (k_ch1 ^ (r0 & 15))) = pk[2];
                    *(LAS v4u*)(L + GL_KL + r1 * 768 + 16 * (k_ch1 ^ (r1 & 15))) = pk[3];
                    const unsigned b0[4] = {pk[2].x, pk[2].y, pk[2].z, pk[2].w}, b1[4] = {pk[3].x, pk[3].y, pk[3].z, pk[3].w};
#pragma unroll
                    for (int jj = 0; jj < 4; ++jj) {
                        *(LAS unsigned*)(L + GL_KT + (8 * k_ch1 + 2 * jj) * 72 + 4 * k_rp) = (b0[jj] & 0xffffu) | (b1[jj] << 16);
                        *(LAS unsigned*)(L + GL_KT + (8 * k_ch1 + 2 * jj + 1) * 72 + 4 * k_rp) = (b0[jj] >> 16) | (b1[jj] & 0xffff0000u); }
                }
                if (t < 128) {
                    const unsigned c0[4] = {pv[0].x, pv[0].y, pv[0].z, pv[0].w}, c1[4] = {pv[1].x, pv[1].y, pv[1].z, pv[1].w};
#pragma unroll
                    for (int jj = 0; jj < 4; ++jj) {
                        *(LAS unsigned*)(L + GL_VT + (8 * v_ch + 2 * jj) * 72 + 4 * v_rp) = (c0[jj] & 0xffffu) | (c1[jj] << 16);
                        *(LAS unsigned*)(L + GL_VT + (8 * v_ch + 2 * jj + 1) * 72 + 4 * v_rp) = (c0[jj] >> 16) | (c1[jj] & 0xffff0000u); }
                }
            }
            f32x4 ebv[3][2];
            { const float* eb = C.EBL + (size_t)(b * 64 + s) * DKT + h * DKH;
#pragma unroll
                for (int p = 0; p < 3; ++p)
#pragma unroll
                    for (int hf = 0; hf < 2; ++hf) ebv[p][hf] = *(const f32x4*)(eb + 32 * (3 * dg + p) + 16 * hf + 4 * g); }
            __builtin_amdgcn_sched_barrier(0);
            GLA_PREFETCH(s + 1 < 64 ? s + 1 : 63);
            __builtin_amdgcn_sched_barrier(0);
            asm volatile("s_waitcnt lgkmcnt(0)" ::: "memory"); __builtin_amdgcn_s_barrier(); asm volatile("" ::: "memory");
            if (w < 3) {
                const int it = (w >= 1) ? 1 : 0, jt = (w == 2) ? 1 : 0;
                f32x4 pa = (f32x4){0.f, 0.f, 0.f, 0.f};
                const int rj = 16 * jt + c, ri = 16 * it + c;
#pragma unroll
                for (int kb = 0; kb < 2; ++kb) {
                    bf16x8 af[6], bf[6];
#pragma unroll
                    for (int q = 0; q < 6; ++q) { const int ks = 6 * kb + q;
                        af[q] = *(const LAS bf16x8*)(L + GL_KL + rj * 768 + 16 * ((4 * ks + g) ^ (rj & 15)));
                        bf[q] = *(const LAS bf16x8*)(L + GL_QL + ri * 768 + 16 * ((4 * ks + g) ^ (ri & 15))); }
                    __builtin_amdgcn_sched_barrier(0);
#pragma unroll
                    for (int q = 0; q < 6; ++q) pa = __builtin_amdgcn_mfma_f32_16x16x32_bf16(af[q], bf[q], pa, 0, 0, 0);
                    __builtin_amdgcn_sched_barrier(0);
                }
                if (it == jt) {
#pragma unroll
                    for (int r = 0; r < 4; ++r) if (4 * g + r > c) pa[r] = 0.f;
                }
                v2u pw; pw.x = pg8::cvt_pk_bf16(pa[0], pa[1]); pw.y = pg8::cvt_pk_bf16(pa[2], pa[3]);
                *(LAS v2u*)(L + GL_P + ri * 72 + (16 * jt + 4 * g) * 2) = pw;
            }
            f32x4 O[2][2];
#pragma unroll
            for (int it = 0; it < 2; ++it)
#pragma unroll
                for (int et = 0; et < 2; ++et) O[it][et] = (f32x4){0.f, 0.f, 0.f, 0.f};
            {
                v2u qlo[3][2], qhi[3][2];
#pragma unroll
                for (int p = 0; p < 3; ++p) { const int cb = 4 * (3 * dg + p);
#pragma unroll
                    for (int it = 0; it < 2; ++it) { const int ri = 16 * it + c;
                        qlo[p][it] = *(const LAS v2u*)(L + GL_QL + ri * 768 + 16 * ((cb + (g >> 1)) ^ (ri & 15)) + 8 * (g & 1));
                        qhi[p][it] = *(const LAS v2u*)(L + GL_QL + ri * 768 + 16 * ((cb + 2 + (g >> 1)) ^ (ri & 15)) + 8 * (g & 1)); } }
                bf16x8 Bf[3][2];
#pragma unroll
                for (int p = 0; p < 3; ++p)
#pragma unroll
                    for (int et = 0; et < 2; ++et) { v4u x; x.x = pg8::cvt_pk_bf16(R[p][0][et][0], R[p][0][et][1]); x.y = pg8::cvt_pk_bf16(R[p][0][et][2], R[p][0][et][3]);
                        x.z = pg8::cvt_pk_bf16(R[p][1][et][0], R[p][1][et][1]); x.w = pg8::cvt_pk_bf16(R[p][1][et][2], R[p][1][et][3]); Bf[p][et] = __builtin_bit_cast(bf16x8, x); }
                __builtin_amdgcn_sched_barrier(0);
#pragma unroll
                for (int p = 0; p < 3; ++p)
#pragma unroll
                    for (int it = 0; it < 2; ++it) { const bf16x8 a = mk_frag(qlo[p][it], qhi[p][it]);
#pragma unroll
                        for (int et = 0; et < 2; ++et) O[it][et] = __builtin_amdgcn_mfma_f32_16x16x32_bf16(a, Bf[p][et], O[it][et], 0, 0, 0); }
            }
            asm volatile("s_waitcnt lgkmcnt(0)" ::: "memory"); __builtin_amdgcn_s_barrier(); asm volatile("" ::: "memory");
            bf16x8 Vf[2];
#pragma unroll
            for (int et = 0; et < 2; ++et) { const int e = 32 * eh + 16 * et + c;
                Vf[et] = mk_frag(*(const LAS v2u*)(L + GL_VT + e * 72 + 16 * g), *(const LAS v2u*)(L + GL_VT + e * 72 + 16 * g + 8)); }
            if (dg == 0) {
#pragma unroll
                for (int it = 0; it < 2; ++it) { const int ri = 16 * it + c;
                    const bf16x8 a = mk_frag(*(const LAS v2u*)(L + GL_P + ri * 72 + 16 * g), *(const LAS v2u*)(L + GL_P + ri * 72 + 16 * g + 8));
#pragma unroll
                    for (int et = 0; et < 2; ++et) O[it][et] = __builtin_amdgcn_mfma_f32_16x16x32_bf16(a, Vf[et], O[it][et], 0, 0, 0); }
            }
#pragma unroll
            for (int it = 0; it < 2; ++it)
#pragma unroll
                for (int et = 0; et < 2; ++et)
#pragma unroll
                    for (int r = 0; r < 4; ++r) *(LAS float*)(L + GL_OS + ((dg * 32 + 16 * it + 4 * g + r) * 64 + 32 * eh + 16 * et + c) * 4) = O[it][et][r];
            {
                v2u klo[3][2], khi[3][2];
#pragma unroll
                for (int p = 0; p < 3; ++p)
#pragma unroll
                    for (int hf = 0; hf < 2; ++hf) { const int d = 32 * (3 * dg + p) + 16 * hf + c;
                        klo[p][hf] = *(const LAS v2u*)(L + GL_KT + d * 72 + 16 * g); khi[p][hf] = *(const LAS v2u*)(L + GL_KT + d * 72 + 16 * g + 8); }
                __builtin_amdgcn_sched_barrier(0);
#pragma unroll
                for (int p = 0; p < 3; ++p)
#pragma unroll
                    for (int hf = 0; hf < 2; ++hf) { const bf16x8 a = mk_frag(klo[p][hf], khi[p][hf]);
#pragma unroll
                        for (int et = 0; et < 2; ++et) R[p][hf][et] = __builtin_amdgcn_mfma_f32_16x16x32_bf16(a, Vf[et], R[p][hf][et], 0, 0, 0); }
            }
            asm volatile("s_waitcnt lgkmcnt(0)" ::: "memory"); __builtin_amdgcn_s_barrier(); asm volatile("" ::: "memory");
            { const int i = t >> 4, e4 = (t & 15) * 4;
                f32x4 o = *(const LAS f32x4*)(L + GL_OS + ((0 * 32 + i) * 64 + e4) * 4);
#pragma unroll
                for (int q = 1; q < 4; ++q) o += *(const LAS f32x4*)(L + GL_OS + ((q * 32 + i) * 64 + e4) * 4);
                *(v2u*)(C.OB + (size_t)(b * SEQ + 32 * s + i) * DVT + h * DVH + 64 * es + e4) = (v2u){pg8::cvt_pk_bf16(o.x, o.y), pg8::cvt_pk_bf16(o.z, o.w)}; }
#pragma unroll
            for (int p = 0; p < 3; ++p)
#pragma unroll
                for (int hf = 0; hf < 2; ++hf)
#pragma unroll
                    for (int et = 0; et < 2; ++et) R[p][hf][et] *= ebv[p][hf];
        }
#undef GLA_PREFETCH
#pragma unroll
        for (int p = 0; p < 3; ++p)
#pragma unroll
            for (int hf = 0; hf < 2; ++hf)
#pragma unroll
                for (int et = 0; et < 2; ++et)
#pragma unroll
                    for (int r = 0; r < 4; ++r)
                        C.out[OFF_GLAP + ((size_t)(b * 4 + h) * DKH + 32 * (3 * dg + p) + 16 * hf + 4 * g + r) * DVH + 64 * es + 32 * eh + 16 * et + c] = R[p][hf][et][r];
        __syncthreads();
    }
}

__device__ __forceinline__ void p6_finalize(const Ctx& C) {
    const int lane = lane_fresh();
    const bool hi = lane >= 32;
    auto do_row = [&](int row) {
        const v4u* op = (const v4u*)(C.OB + (size_t)row * DVT) + lane;
        const v4u* gp = (const v4u*)(C.Z + (size_t)row * ZW + ZC_G) + lane;
        v4u ov[6], gv[6];
#pragma unroll
        for (int jj = 0; jj < 6; ++jj) ov[jj] = op[64 * jj];
#pragma unroll
        for (int jj = 0; jj < 6; ++jj) gv[jj] = gp[64 * jj];
        float ss[6];
#pragma unroll
        for (int jj = 0; jj < 6; ++jj) { const float a0 = bflo(ov[jj].x), a1 = bfhi(ov[jj].x), a2 = bflo(ov[jj].y), a3 = bfhi(ov[jj].y), a4 = bflo(ov[jj].z), a5 = bfhi(ov[jj].z), a6 = bflo(ov[jj].w), a7 = bfhi(ov[jj].w);
            ss[jj] = ((a0 * a0 + a1 * a1) + (a2 * a2 + a3 * a3)) + ((a4 * a4 + a5 * a5) + (a6 * a6 + a7 * a7)); }
        const float q0 = wave_sum(ss[0] + (hi ? 0.f : ss[1])), q1 = wave_sum((hi ? ss[1] : 0.f) + ss[2]), q2 = wave_sum(ss[3] + (hi ? 0.f : ss[4])), q3 = wave_sum((hi ? ss[4] : 0.f) + ss[5]);
        const float r0 = 1.0f / sqrtf(q0 * (1.0f / DVH) + EPS), r1 = 1.0f / sqrtf(q1 * (1.0f / DVH) + EPS), r2 = 1.0f / sqrtf(q2 * (1.0f / DVH) + EPS), r3 = 1.0f / sqrtf(q3 * (1.0f / DVH) + EPS);
        v4u* mp = (v4u*)(C.MIX + (size_t)row * D + DPOOL) + lane;
#pragma unroll
        for (int jj = 0; jj < 6; ++jj) {
            const float rs = jj == 0 ? r0 : jj == 1 ? (hi ? r1 : r0) : jj == 2 ? r1 : jj == 3 ? r2 : jj == 4 ? (hi ? r3 : r2) : r3;
            const float* gn = C.g_gla_out + 8 * (64 * jj + lane);
            const f32x4 g0 = *(const f32x4*)gn, g1 = *(const f32x4*)(gn + 4);
            const float y0 = pg8::silu_f(bflo(gv[jj].x)) * (bflo(ov[jj].x) * rs * g0.x), y1 = pg8::silu_f(bfhi(gv[jj].x)) * (bfhi(ov[jj].x) * rs * g0.y);
            const float y2 = pg8::silu_f(bflo(gv[jj].y)) * (bflo(ov[jj].y) * rs * g0.z), y3 = pg8::silu_f(bfhi(gv[jj].y)) * (bfhi(ov[jj].y) * rs * g0.w);
            const float y4 = pg8::silu_f(bflo(gv[jj].z)) * (bflo(ov[jj].z) * rs * g1.x), y5 = pg8::silu_f(bfhi(gv[jj].z)) * (bfhi(ov[jj].z) * rs * g1.y);
            const float y6 = pg8::silu_f(bflo(gv[jj].w)) * (bflo(ov[jj].w) * rs * g1.z), y7 = pg8::silu_f(bfhi(gv[jj].w)) * (bfhi(ov[jj].w) * rs * g1.w);
            mp[64 * jj] = (v4u){pk2(y0, y1), pk2(y2, y3), pk2(y4, y5), pk2(y6, y7)}; }
    };
    for (int bi = (int)blockIdx.x; bi < TP / 32; bi += C.G)
#pragma unroll 1
        for (int k = 0; k < 4; ++k) do_row(32 * bi + C.wave + 8 * k);
    for (int n = (int)blockIdx.x; n < NS; n += C.G) if (C.wave == (n & 7)) do_row(TP + n);
}

__device__ __forceinline__ void p11_final_norm(const Ctx& C) {
    const int lane = lane_fresh();
    auto do_row = [&](int row) {
        const v4u* xv = (const v4u*)(C.OPB + (size_t)row * D) + lane;
        v4u w[8]; float s = 0.f;
#pragma unroll
        for (int j = 0; j < 8; ++j) w[j] = xv[64 * j];
#pragma unroll
        for (int j = 0; j < 8; ++j) { const float a0 = bflo(w[j].x), a1 = bfhi(w[j].x), a2 = bflo(w[j].y), a3 = bfhi(w[j].y), a4 = bflo(w[j].z), a5 = bfhi(w[j].z), a6 = bflo(w[j].w), a7 = bfhi(w[j].w);
            s += ((a0 * a0 + a1 * a1) + (a2 * a2 + a3 * a3)) + ((a4 * a4 + a5 * a5) + (a6 * a6 + a7 * a7)); }
        const float rstd = 1.0f / sqrtf(wave_sum(s) * (1.0f / D) + EPS);
        float* orow = C.out + (size_t)row * D;
#pragma unroll
        for (int j = 0; j < 8; ++j) { const int c = 8 * (64 * j + lane);
            const f32x4 g0 = *(const f32x4*)(C.g_final + c), g1 = *(const f32x4*)(C.g_final + c + 4);
            const f32x4 x0 = (f32x4){bflo(w[j].x), bfhi(w[j].x), bflo(w[j].y), bfhi(w[j].y)}, x1 = (f32x4){bflo(w[j].z), bfhi(w[j].z), bflo(w[j].w), bfhi(w[j].w)};
            *(f32x4*)(orow + c) = x0 * rstd * g0; *(f32x4*)(orow + c + 4) = x1 * rstd * g1; }
    };
    for (int bi = (int)blockIdx.x; bi < TP / 32; bi += C.G)
#pragma unroll 1
        for (int k = 0; k < 4; ++k) do_row(32 * bi + C.wave + 8 * k);
    const int t = threadIdx.x, w = C.wave;
    for (int n = blockIdx.x; n < NS; n += C.G) {
        const int row = TP + n;
        f32x4 v[2]; float ssq;
        sample_row_from_slabs<16>(C.X1 + (size_t)row * D, C.MOD + (size_t)(4 + n) * NMOD + 5 * D, C.XS, n, v, ssq, (LAS float*)C.lds, t, w);
        const float rstd = 1.0f / sqrtf(ssq * (1.0f / D) + EPS);
#pragma unroll
        for (int j = 0; j < 2; ++j) { const int c = 4 * t + 2048 * j;
            *(f32x4*)(C.out + (size_t)row * D + c) = v[j] * rstd * *(const f32x4*)(C.g_final + c); }
    }
}

__device__ __forceinline__ void p9_fixup(const Ctx& C) {
    const int nth = C.G * NWAVES * 64;
    for (int it = blockIdx.x * NWAVES * 64 + threadIdx.x; it < NS * (OV_COLS / 8); it += nth) {
        const int n = it / (OV_COLS / 8), col = (it % (OV_COLS / 8)) * 8;
        f32x4 a0 = (f32x4){0.f, 0.f, 0.f, 0.f}, a1 = a0, b0 = a0, b1 = a0;
#pragma unroll
        for (int ks = 0; ks < OV_KS; ++ks) { const float* pa = C.SS + ((size_t)(ks * 2) * NS + n) * OV_COLS + col; const float* pb = pa + (size_t)NS * OV_COLS;
            a0 += *(const f32x4*)pa; a1 += *(const f32x4*)(pa + 4); b0 += *(const f32x4*)pb; b1 += *(const f32x4*)(pb + 4); }
        v4u w;
        w.x = pg8::cvt_pk_bf16(pg8::silu_f(a0.x) * b0.x, pg8::silu_f(a0.y) * b0.y); w.y = pg8::cvt_pk_bf16(pg8::silu_f(a0.z) * b0.z, pg8::silu_f(a0.w) * b0.w);
        w.z = pg8::cvt_pk_bf16(pg8::silu_f(a1.x) * b1.x, pg8::silu_f(a1.y) * b1.y); w.w = pg8::cvt_pk_bf16(pg8::silu_f(a1.z) * b1.z, pg8::silu_f(a1.w) * b1.w);
        const int blk = col >> 7, pn = blk < OV_N / 2 ? OV_PA + blk : OV_PB + blk;
        *(v4u*)(C.ACT + (size_t)(TP + n) * DFF + pn * 128 + (col & 127)) = w;
    }
}

struct Args { const float* in[21]; float* out; unsigned char* ws; int ph_lo, ph_hi, li, pad; };
__global__ void __launch_bounds__(NWAVES * 64, 2) fwd_kernel(Args args) {
    extern __shared__ __attribute__((aligned(16))) unsigned char lds[];
    Ctx C;
    C.lds = (LAS unsigned char*)lds;
    C.wave = __builtin_amdgcn_readfirstlane(threadIdx.x >> 6);
    C.G = gridDim.x; C.gw = blockIdx.x * NWAVES + C.wave; C.NGW = C.G * NWAVES;
    C.x_prompt = args.in[0]; C.x_sample = args.in[1]; C.state_pool = args.in[2]; C.state_gla = args.in[3]; C.c_prompt = args.in[4]; C.c_sample = args.in[5];
    C.w_ada = args.in[6]; C.b_ada = args.in[7]; C.g_norm1 = args.in[8]; C.w_in = args.in[9]; C.w_pool = args.in[10]; C.pool_scale = args.in[11]; C.w_a2 = args.in[12];
    C.b_a = args.in[13]; C.g_gla_out = args.in[14]; C.w_out = args.in[15]; C.g_norm2 = args.in[16]; C.w_ff1 = args.in[17]; C.w_ff3 = args.in[18]; C.w_ff2 = args.in[19]; C.g_final = args.in[20];
    C.out = args.out;
    unsigned char* ws = args.ws;
    C.MOD = (float*)(ws + WS_MOD); C.SC = (bf16*)(ws + WS_SC); C.WinT = (bf16*)(ws + WS_WIN); C.WaT = (bf16*)(ws + WS_WA); C.WoutT = (bf16*)(ws + WS_WOUT);
    C.W13T = (bf16*)(ws + WS_W13); C.Wff2T = (bf16*)(ws + WS_WFF2); C.WpT = (bf16*)(ws + WS_WP); C.H = (bf16*)(ws + WS_H); C.Z = (bf16*)(ws + WS_Z);
    C.QT = (bf16*)(ws + WS_QT); C.KT = (bf16*)(ws + WS_KT); C.EBL = (float*)(ws + WS_EBL); C.LAS_ = (float*)(ws + WS_LAS); C.DP = (bf16*)(ws + WS_DP);
    C.OB = (bf16*)(ws + WS_OB); C.MIX = (bf16*)(ws + WS_MIX); C.X1 = (float*)(ws + WS_X1); C.X1B = (bf16*)(ws + WS_X1); C.OPB = (bf16*)(ws + WS_X1 + (size_t)TP * D * 2); C.ACT = (bf16*)(ws + WS_ACT); C.ZS = (float*)(ws + WS_ZS); C.XS = (float*)(ws + WS_XS); C.SS = (float*)(ws + WS_SS);
    volatile LAS unsigned* MISC = (volatile LAS unsigned*)(C.lds + MISC_OFF);
    for (int u = threadIdx.x; u < (LDS_BYTES - MISC_OFF) / 4; u += NWAVES * 64) MISC[u] = 0u;
    __syncthreads();
    unsigned* ctl = (unsigned*)(ws + WS_CTL);
    XcdBarrier bar; bar.bar = ctl + CW_BAR; bar.x = 0; bar.st = nullptr;
    if (MK_LAUNCHES == 1) bar = xcd_barrier_post(ctl + CW_BAR, MISC + 8);
#define GRID_BAR() do { if (MK_LAUNCHES == 1) xcd_barrier(bar); } while (0)
    const int lo = args.ph_lo, hi = args.ph_hi;
#define IN(k) (lo <= (k) && (k) < hi)
#define BOTH(k) (IN(k) && IN((k) + 1))

#define DUP(k) ((PROBE_DUP >> (k)) & 1)
    if (IN(0)) { p0_small(C); if (BOTH(0)) GRID_BAR(); }
    if (IN(1)) { p1_adaln(C); if (DUP(1)) { GRID_BAR(); p1_adaln(C); } if (BOTH(1)) GRID_BAR(); }
    if (IN(2)) { norm_rows<false>(C, C.x_prompt, nullptr, C.x_sample, C.g_norm1, 0, D, C.H, nullptr, 0, nullptr); if (DUP(2)) { GRID_BAR(); norm_rows<false>(C, C.x_prompt, nullptr, C.x_sample, C.g_norm1, 0, D, C.H, nullptr, 0, nullptr); } if (BOTH(2)) GRID_BAR(); }
    if (IN(3)) {
        pg8::Gemm g{C.H, C.WinT, D, D, 0}; pg8::TwoPartOrder S; S.init(TP / 256, ZW / 256, D / 64, 4, 16, 16, 4, C.G, (int)blockIdx.x);
        pg8::EpiZ E{C.Z, ZW, C.ZS};
        pg8::gemm_phase<pg8::EpiZ, pg8::TwoPartOrder, true, true>(C.lds, g, S, E);
        if (DUP(3)) { GRID_BAR(); pg8::gemm_phase<pg8::EpiZ, pg8::TwoPartOrder, true, true>(C.lds, g, S, E); }
        if (BOTH(3)) GRID_BAR();
    }
    if (IN(4)) { p4_prep(C); if (DUP(4)) { GRID_BAR(); p4_prep(C); } if (BOTH(4)) GRID_BAR(); }
    if (IN(5)) { p5_gla_prompt(C); if (DUP(5)) { GRID_BAR(); p5_gla_prompt(C); } p5_sample_pool(C); p5_gla_sample_q(C, ctl + CW_Q); if (BOTH(5)) GRID_BAR(); }
    if (IN(6)) {
        p6_finalize(C);
        for (int rr = 0; rr < PROBE_REP6; ++rr) { GRID_BAR(); p6_finalize(C); }
        __syncthreads();
        pg8::Gemm g{C.DP, C.WpT, DPOOL, 256, 256}; pg8::TwoPartOrder S; S.init(MP / 256, 4, 4, 0, 0, 0, 0, C.G, (int)blockIdx.x);
        pg8::EpiPool E{C.MIX, D, C.pool_scale};
        pg8::gemm_phase<pg8::EpiPool, pg8::TwoPartOrder, true, true>(C.lds, g, S, E);
        if (DUP(6)) { GRID_BAR(); p6_finalize(C); __syncthreads(); pg8::gemm_phase<pg8::EpiPool, pg8::TwoPartOrder, true, true>(C.lds, g, S, E); }
        if (BOTH(6)) GRID_BAR();
    }
    if (IN(7)) {
        pg8::Gemm g{C.MIX, C.WoutT, D, D, 0}; pg8::TwoPartOrder S; S.init(TP / 256, D / 256, D / 64, 8, 8, 8, 8, C.G, (int)blockIdx.x);
        pg8::EpiResB<false> E{C.x_prompt, nullptr, C.MOD + 2 * D, C.X1B, C.XS};
        pg8::gemm_phase<pg8::EpiResB<false>, pg8::TwoPartOrder, true, true>(C.lds, g, S, E);
        if (DUP(7)) { GRID_BAR(); pg8::gemm_phase<pg8::EpiResB<false>, pg8::TwoPartOrder, true, true>(C.lds, g, S, E); }
        if (BOTH(7)) GRID_BAR();
    }
    if (IN(8)) { norm_rows<true>(C, nullptr, C.X1B, C.x_sample, C.g_norm2, 3 * D, 4 * D, C.H, C.XS, 2 * D, C.X1); if (DUP(8)) { GRID_BAR(); norm_rows<true>(C, nullptr, C.X1B, C.x_sample, C.g_norm2, 3 * D, 4 * D, C.H, C.XS, 2 * D, C.X1); } if (BOTH(8)) GRID_BAR(); }
    if (IN(9)) {
        pg8::Gemm g{C.H, C.W13T, D, D, 0}; pg8::TwoPartOrder S; S.init(TP / 256, 2 * DFF / 256, D / 64, 1, D / 64, D / 64, 1, C.G, (int)blockIdx.x); S.ovf = (C.G == 256) ? OV_KS : 0;
        pg8::EpiSwiGLU E{C.ACT, DFF, C.SS, OV_SPLIT, OV_PA, OV_PB, OV_COLS};
        pg8::gemm_phase<pg8::EpiSwiGLU, pg8::TwoPartOrder, true, true>(C.lds, g, S, E);
        if (DUP(9)) { GRID_BAR(); pg8::gemm_phase<pg8::EpiSwiGLU, pg8::TwoPartOrder, true, true>(C.lds, g, S, E); }
        if (BOTH(9)) GRID_BAR();
    }
    if (IN(10) && C.G == 256) { p9_fixup(C); GRID_BAR(); }
    if (IN(10)) {
        pg8::Gemm g{C.ACT, C.Wff2T, DFF, DFF, 0}; pg8::TwoPartOrder S; S.init(TP / 256, D / 256, DFF / 64, 16, 12, 10, 6, C.G, (int)blockIdx.x, C.G == 256 ? 1 : 0);
        pg8::EpiResB<true> E{nullptr, C.X1B, C.MOD + 5 * D, C.OPB, C.XS};
        pg8::gemm_phase<pg8::EpiResB<true>, pg8::TwoPartOrder, true, true>(C.lds, g, S, E);
        if (DUP(10)) { GRID_BAR(); pg8::gemm_phase<pg8::EpiResB<true>, pg8::TwoPartOrder, true, true>(C.lds, g, S, E); }
        if (BOTH(10)) GRID_BAR();
    }
    if (IN(11)) { p11_final_norm(C); }
#undef IN
#undef BOTH
}

extern "C" void kernel_launch(void* const* d_in, const int* in_sizes, int n_in, void* d_out, int out_size, void* d_ws, size_t ws_size, hipStream_t stream) {
    static int grid = 0;
    if (grid == 0) {
        if (n_in != 21 || ws_size < WS_END) { fprintf(stderr, "kernel_launch: unexpected shapes (n_in %d, ws %zu < %zu)\n", n_in, ws_size, (size_t)WS_END); grid = -1; return; }
        int dev = 0, cus = 0, per_cu = 0;
        if (hipGetDevice(&dev) != hipSuccess || hipDeviceGetAttribute(&cus, hipDeviceAttributeMultiprocessorCount, dev) != hipSuccess) { grid = -1; return; }
        if (hipFuncSetAttribute((const void*)fwd_kernel, hipFuncAttributeMaxDynamicSharedMemorySize, LDS_BYTES) != hipSuccess) { fprintf(stderr, "kernel_launch: hipFuncSetAttribute failed\n"); grid = -1; return; }
        if (hipOccupancyMaxActiveBlocksPerMultiprocessor(&per_cu, (const void*)fwd_kernel, NWAVES * 64, LDS_BYTES) != hipSuccess || per_cu < 1)
            fprintf(stderr, "kernel_launch: occupancy query reports %d workgroups per CU\n", per_cu);
        (void)hipGetLastError();
        grid = cus;
    }
    if (grid < 0) return;
    if (hipMemsetAsync((char*)d_ws + WS_CTL, 0, CTL_ZERO_BYTES, stream) != hipSuccess) return;
    Args a{};
    for (int i = 0; i < 21; ++i) a.in[i] = (const float*)d_in[i];
    a.out = (float*)d_out; a.ws = (unsigned char*)d_ws; a.pad = 0;
    for (int li = 0; li < MK_LAUNCHES; ++li) {
        if (MK_LAUNCHES == 1) { a.ph_lo = 0; a.ph_hi = NPHASES; } else { a.ph_lo = li; a.ph_hi = li + 1; }
        a.li = li;
        hipLaunchKernelGGL(fwd_kernel, dim3(grid), dim3(NWAVES * 64), LDS_BYTES, stream, a);
        if (hipPeekAtLastError() != hipSuccess) { fprintf(stderr, "kernel_launch: launch %d failed\n", li); break; }
    }
}
```

```cpp
#include <hip/hip_runtime.h>
#include <cstdio>
#include <cstdint>

#ifndef PROBE_REP6
#define PROBE_REP6 0
#endif
#ifndef PROBE_REP1
#define PROBE_REP1 0
#endif
#ifndef TR_SPREAD
#define TR_SPREAD 1
#endif
#ifndef PROBE_DUP
#define PROBE_DUP 0
#endif
#ifndef MK_LAUNCHES
#define MK_LAUNCHES 1
#endif

namespace pg8 {
#define PG8_LAS __attribute__((address_space(3)))
typedef unsigned short bf16_t;
typedef short bf16x8 __attribute__((ext_vector_type(8)));
typedef float f32x4 __attribute__((ext_vector_type(4)));
typedef unsigned u32x4 __attribute__((ext_vector_type(4)));
constexpr int BM = 256, BK = 64, HALF = 128, HTB = HALF * BK * 2  , STAGE_BYTES = 8 * HTB, NXCD = 8, WGM = 8;

__host__ __device__ __forceinline__ int lds_byte(int r, int c) { const int st = (r >> 4) * 2 + (c >> 5), rr = r & 15, cc = c & 31, ob = rr * 64 + cc * 2; return st * 1024 + (ob ^ (((ob >> 9) & 1) << 5)); }
__host__ __device__ __forceinline__ void stage_rc(int b, int& R, int& C) { const int st = b / 1024, sb = b % 1024, swz = sb ^ (((sb >> 9) & 1) << 5); R = (st >> 1) * 16 + swz / 64; C = (st & 1) * 32 + (swz % 64) / 2; }
__host__ __device__ __forceinline__ int perm32(int rho) { const int n = rho >> 4, i = rho & 15; return 8 * (i >> 2) + 4 * n + (i & 3); }

struct Unit { int pm, pn, kb, nkt, ks; bool half, ksp; };
struct Gemm { const bf16_t* A; const bf16_t* Bt; int lda, ldb, a_pn_off; };

struct TwoPartOrder {
    int nMp, nN, nP, nS, G, c, KT, nks, kt_a, kt_b, n_a, early, ovf;
    __host__ __device__ void init(int nMp_, int nN_, int KT_, int nks_, int kt_a_, int kt_b_, int n_a_, int G_, int c_, int early_ = 0) {
        early = early_; ovf = 0; nMp = nMp_; nN = nN_; nP = nMp * nN; KT = KT_; nks = nks_; kt_a = kt_a_; kt_b = kt_b_; n_a = n_a_; nS = nN * nks; G = G_; c = c_; }
    __host__ __device__ bool next(int i, Unit& u) const {
        if (early && (c & 1)) {
            if (i == 0) { u.pm = nMp; u.pn = c % nN; u.ks = c / nN; u.half = true; u.ksp = false; u.kb = u.ks < n_a ? u.ks * kt_a : n_a * kt_a + (u.ks - n_a) * kt_b; u.nkt = u.ks < n_a ? kt_a : kt_b; return true; }
            i -= 1;
            if ((long)i * G + c >= nP) return false;
        }
        const long L = (long)i * G + c;
        if (L < nP) {
            int wgid = (int)L; { const int q = nP / NXCD, r = nP % NXCD, xcd = wgid % NXCD, off = wgid / NXCD; wgid = (xcd < r ? xcd * (q + 1) : r * (q + 1) + (xcd - r) * q) + off; }
            const int nig = WGM * nN, gid = wgid / nig, fm = gid * WGM, gsz = (nMp - fm) < WGM ? (nMp - fm) : WGM;
            u.pm = fm + ((wgid % nig) % gsz); u.pn = (wgid % nig) / gsz; u.kb = 0; u.nkt = KT; u.ks = 0; u.half = false; u.ksp = false; return true;
        }
        const int shift = nP % G, i0 = nP / G, m = i - i0, cr = (c - shift + G) % G;
        if (ovf > 0 && m >= 1) {
            const int J0 = G - shift, q = (m - 1) * G + c;
            if (q >= (nS - J0) * ovf) return false;
            const int k = q / ovf, nh = (nS - J0) / 2;
            u.pm = nMp; u.pn = k < nh ? nN / 2 - nh + k : nN - 2 * nh + k; u.ks = q % ovf; u.half = true; u.ksp = true; u.nkt = KT / ovf; u.kb = u.ks * u.nkt; return true;
        }
        const int j = (m == 0) ? cr : (G - shift) + (m - 1) * G + cr;
        if (j >= nS) return false;
        u.pm = nMp; u.pn = j % nN; u.ks = j / nN; u.half = true; u.ksp = false;
        if (ovf > 0) { const int nh = (nS - (G - shift)) / 2; u.pn = j < nN / 2 - nh ? j : j + nh; }
        u.kb = u.ks < n_a ? u.ks * kt_a : n_a * kt_a + (u.ks - n_a) * kt_b; u.nkt = u.ks < n_a ? kt_a : kt_b; return true;
    }
    __device__ __forceinline__ void a_ready(const Unit&) const {}
    __device__ __forceinline__ void done(const Unit&) const {}
};

__device__ __forceinline__ unsigned cvt_pk_bf16(float lo, float hi) { unsigned r; asm volatile("v_cvt_pk_bf16_f32 %0, %1, %2" : "=v"(r) : "v"(lo), "v"(hi)); return r; }
__device__ __forceinline__ float silu_f(float x) { return x * __builtin_amdgcn_rcpf(1.0f + __expf(-x)); }

struct EpiZ {
    static constexpr bool PERM = true, AFTER_DRAIN = false;
    bf16_t* O; int ldc; float* slab;
    __device__ __forceinline__ void operator()(const f32x4 (&acc)[2][2][4][2], const Unit& u, int wr, int wc, int fr, int fq) const {
        const int row0 = u.pm * BM + wr * 64 + fr, col0 = u.pn * BM + wc * 32 + 8 * fq;
        if (!u.half) {
#pragma unroll
            for (int ai = 0; ai < 2; ++ai)
#pragma unroll
                for (int m = 0; m < 4; ++m) { bf16_t* rowp = O + (size_t)(row0 + ai * HALF + m * 16) * ldc + col0;
#pragma unroll
                    for (int bj = 0; bj < 2; ++bj) { const f32x4 v0 = acc[ai][bj][m][0], v1 = acc[ai][bj][m][1];
                        u32x4 w; w.x = cvt_pk_bf16(v0[0], v0[1]); w.y = cvt_pk_bf16(v0[2], v0[3]); w.z = cvt_pk_bf16(v1[0], v1[1]); w.w = cvt_pk_bf16(v1[2], v1[3]);
                        *(u32x4*)(rowp + bj * HALF) = w; } }
        } else {
#pragma unroll
            for (int m = 0; m < 4; ++m) { float* rowp = slab + ((size_t)u.ks * 128 + (wr * 64 + fr + m * 16)) * ldc + col0;
#pragma unroll
                for (int bj = 0; bj < 2; ++bj) { *(f32x4*)(rowp + bj * HALF) = acc[0][bj][m][0]; *(f32x4*)(rowp + bj * HALF + 4) = acc[0][bj][m][1]; } }
        }
    }
};
struct EpiPool {
    static constexpr bool PERM = true, AFTER_DRAIN = false;
    bf16_t* O; int ldc; const float* scale;
    __device__ __forceinline__ void operator()(const f32x4 (&acc)[2][2][4][2], const Unit& u, int wr, int wc, int fr, int fq) const {
        const int row0 = u.pm * BM + wr * 64 + fr, col0 = u.pn * BM + wc * 32 + 8 * fq;
        f32x4 sv[2][2];
#pragma unroll
        for (int bj = 0; bj < 2; ++bj)
#pragma unroll
            for (int n = 0; n < 2; ++n) sv[bj][n] = *(const f32x4*)(scale + col0 + bj * HALF + 4 * n);
#pragma unroll
        for (int ai = 0; ai < 2; ++ai)
#pragma unroll
            for (int m = 0; m < 4; ++m) { bf16_t* rowp = O + (size_t)(row0 + ai * HALF + m * 16) * ldc + col0;
#pragma unroll
                for (int bj = 0; bj < 2; ++bj) { const f32x4 v0 = acc[ai][bj][m][0] * sv[bj][0], v1 = acc[ai][bj][m][1] * sv[bj][1];
                    u32x4 w; w.x = cvt_pk_bf16(v0[0], v0[1]); w.y = cvt_pk_bf16(v0[2], v0[3]); w.z = cvt_pk_bf16(v1[0], v1[1]); w.w = cvt_pk_bf16(v1[2], v1[3]);
                    *(u32x4*)(rowp + bj * HALF) = w; } }
    }
};
struct EpiSwiGLU {
    static constexpr bool PERM = true, AFTER_DRAIN = false;
    bf16_t* O; int ldc; float* slab; int psplit, pa, pb, lds_;
    __device__ __forceinline__ void operator()(const f32x4 (&acc)[2][2][4][2], const Unit& u, int wr, int wc, int fr, int fq) const {
        const int row0 = u.pm * BM + wr * 64 + fr, col0 = u.pn * HALF + wc * 32 + 8 * fq;
        if (!u.ksp) {
#pragma unroll
            for (int ai = 0; ai < 2; ++ai) {
                if (ai == 1 && u.half) break;
#pragma unroll
                for (int m = 0; m < 4; ++m) { bf16_t* rowp = O + (size_t)(row0 + ai * HALF + m * 16) * ldc + col0;
                    const f32x4 a0 = acc[ai][0][m][0], a1 = acc[ai][0][m][1], b0 = acc[ai][1][m][0], b1 = acc[ai][1][m][1];
                    float o[8];
#pragma unroll
                    for (int j = 0; j < 4; ++j) { o[j] = silu_f(a0[j]) * b0[j]; o[4 + j] = silu_f(a1[j]) * b1[j]; }
                    u32x4 w; w.x = cvt_pk_bf16(o[0], o[1]); w.y = cvt_pk_bf16(o[2], o[3]); w.z = cvt_pk_bf16(o[4], o[5]); w.w = cvt_pk_bf16(o[6], o[7]);
                    *(u32x4*)rowp = w; } }
        } else {
            const int cs = (u.pn - (u.pn < psplit ? pa : pb)) * HALF + wc * 32 + 8 * fq;
#pragma unroll
            for (int m = 0; m < 4; ++m)
#pragma unroll
                for (int bj = 0; bj < 2; ++bj) { float* rowp = slab + ((size_t)(u.ks * 2 + bj) * 128 + (wr * 64 + fr + m * 16)) * lds_ + cs;
                    *(f32x4*)rowp = acc[0][bj][m][0]; *(f32x4*)(rowp + 4) = acc[0][bj][m][1]; }
        }
    }
};
template <bool XBF>
struct EpiResB {
    static constexpr bool PERM = true, AFTER_DRAIN = false;
    const float* xf; const bf16_t* xb; const float* gate;
    bf16_t* O; float* slab;
    __device__ __forceinline__ void operator()(const f32x4 (&acc)[2][2][4][2], const Unit& u, int wr, int wc, int fr, int fq) const {
        const int row0 = u.pm * BM + wr * 64 + fr, col0 = u.pn * BM + wc * 32 + 8 * fq;
        if (!u.half) {
            const float* gr = gate + (size_t)((u.pm * BM) >> 11) * 24576 + col0;
            f32x4 gv[2][2];
#pragma unroll
            for (int bj = 0; bj < 2; ++bj)
#pragma unroll
                for (int n = 0; n < 2; ++n) gv[bj][n] = *(const f32x4*)(gr + bj * HALF + 4 * n);
#pragma unroll
            for (int ai = 0; ai < 2; ++ai)
#pragma unroll
                for (int m = 0; m < 4; ++m) { const int row = row0 + ai * HALF + m * 16;
                    bf16_t* orow = O + (size_t)row * 4096 + col0;
                    f32x4 xv[2][2];
                    if (XBF) { const bf16_t* xr = xb + (size_t)row * 4096 + col0;
#pragma unroll
                        for (int bj = 0; bj < 2; ++bj) { const u32x4 w = *(const u32x4*)(xr + bj * HALF);
                            xv[bj][0] = (f32x4){__uint_as_float(w.x << 16), __uint_as_float(w.x & 0xffff0000u), __uint_as_float(w.y << 16), __uint_as_float(w.y & 0xffff0000u)};
                            xv[bj][1] = (f32x4){__uint_as_float(w.z << 16), __uint_as_float(w.z & 0xffff0000u), __uint_as_float(w.w << 16), __uint_as_float(w.w & 0xffff0000u)}; }
                    } else { const float* xr = xf + (size_t)row * 4096 + col0;
#pragma unroll
                        for (int bj = 0; bj < 2; ++bj)
#pragma unroll
                            for (int n = 0; n < 2; ++n) xv[bj][n] = *(const f32x4*)(xr + bj * HALF + 4 * n); }
#pragma unroll
                    for (int bj = 0; bj < 2; ++bj) { const f32x4 v0 = xv[bj][0] + gv[bj][0] * acc[ai][bj][m][0], v1 = xv[bj][1] + gv[bj][1] * acc[ai][bj][m][1];
                        u32x4 w; w.x = cvt_pk_bf16(v0[0], v0[1]); w.y = cvt_pk_bf16(v0[2], v0[3]); w.z = cvt_pk_bf16(v1[0], v1[1]); w.w = cvt_pk_bf16(v1[2], v1[3]);
                        *(u32x4*)(orow + bj * HALF) = w; }
                    if (m & 1) asm volatile("" ::: "memory"); }
        } else {
#pragma unroll
            for (int m = 0; m < 4; ++m) { float* rowp = slab + ((size_t)u.ks * 128 + (wr * 64 + fr + m * 16)) * 4096 + col0;
#pragma unroll
                for (int bj = 0; bj < 2; ++bj) { *(f32x4*)(rowp + bj * HALF) = acc[0][bj][m][0]; *(f32x4*)(rowp + bj * HALF + 4) = acc[0][bj][m][1]; } }
        }
    }
};

template <class Epi, class Sched, bool ALIGN_EPI = false, bool SP2 = false>
__device__ __forceinline__ void gemm_phase(PG8_LAS unsigned char* lds, const Gemm g, const Sched& S, const Epi& E) {
    const int tid = threadIdx.x, wid = __builtin_amdgcn_readfirstlane(tid >> 6), lane = tid & 63, wr = wid >> 2, wc = wid & 3, fr = lane & 15, fq = lane >> 4;
    unsigned voffA[2], voffB[2];
#pragma unroll
    for (int i = 0; i < 2; ++i) { int R, C; stage_rc(tid * 16 + i * 8192, R, C); const int Rb = Epi::PERM ? ((R & ~31) + perm32(R & 31)) : R;
        voffA[i] = (unsigned)(R * g.lda + C) * 2u; voffB[i] = (unsigned)(Rb * g.ldb + C) * 2u; }
    const size_t kstep = (size_t)(BK * 2);
    const size_t hstepA = (size_t)HALF * g.lda * 2, hstepB = (size_t)HALF * g.ldb * 2;
    const size_t tstepA = 2 * hstepA, tstepB = 2 * hstepB;
    const unsigned ldsw = (unsigned)wid * 1024u;
    const int aoff = lds_byte(wr * 64 + fr, fq * 8), boff = lds_byte(wc * 32 + fr, fq * 8);
#define PG8_SA(b, h) (((b) * 2 + (h)) * HTB)
#define PG8_SB(b, h) ((4 + (b) * 2 + (h)) * HTB)
#define PG8_STAGE(bufoff, gbase, voff) do { _Pragma("unroll") for (int _i = 0; _i < 2; ++_i) \
        __builtin_amdgcn_global_load_lds((const unsigned*)((const char*)(gbase) + (voff)[_i]), (PG8_LAS unsigned*)(lds + (bufoff) + ldsw + _i * 8192), 16, 0, 0); } while (0)
#define PG8_LDA(dst, b, h) do { _Pragma("unroll") for (int m = 0; m < 4; ++m) _Pragma("unroll") for (int k = 0; k < 2; ++k) dst[m][k] = *(const PG8_LAS bf16x8*)(lds + PG8_SA(b, h) + aoff + m * 2048 + k * 1024); } while (0)
#define PG8_LDB(dst, b, h) do { _Pragma("unroll") for (int n = 0; n < 2; ++n) _Pragma("unroll") for (int k = 0; k < 2; ++k) dst[n][k] = *(const PG8_LAS bf16x8*)(lds + PG8_SB(b, h) + boff + n * 2048 + k * 1024); } while (0)
#define PG8_MMA(ai, bj, At, Bt) do { __builtin_amdgcn_s_setprio(1); _Pragma("unroll") for (int m = 0; m < 4; ++m) _Pragma("unroll") for (int n = 0; n < 2; ++n) _Pragma("unroll") for (int k = 0; k < 2; ++k) \
        acc[ai][bj][m][n] = __builtin_amdgcn_mfma_f32_16x16x32_bf16(Bt[n][k], At[m][k], acc[ai][bj][m][n], 0, 0, 0); __builtin_amdgcn_s_setprio(0); } while (0)
#define PG8_WAIT_V(n) asm volatile("s_waitcnt vmcnt(" #n ")" ::: "memory")
#define PG8_WAIT_L(n) asm volatile("s_waitcnt lgkmcnt(" #n ")" ::: "memory")
#define PG8_BAR __builtin_amdgcn_s_barrier()
#define PG8_SCHED __builtin_amdgcn_sched_barrier(0)
    Unit cur, nxt; int ui = 0;
    if (!S.next(0, cur)) return;
    f32x4 acc[2][2][4][2];
#pragma unroll
    for (int a = 0; a < 2; ++a)
#pragma unroll
        for (int b = 0; b < 2; ++b)
#pragma unroll
            for (int m = 0; m < 4; ++m)
#pragma unroll
                for (int n = 0; n < 2; ++n) acc[a][b][m][n] = (f32x4){0.f, 0.f, 0.f, 0.f};
    bf16x8 At[4][2], B0[2][2], B1[2][2];
    const char* cA = (const char*)g.A + (size_t)cur.pm * tstepA + (size_t)cur.pn * (size_t)g.a_pn_off * 2 + (size_t)cur.kb * kstep; const char* cB = (const char*)g.Bt + (size_t)cur.pn * tstepB + (size_t)cur.kb * kstep;
    S.a_ready(cur);
    if constexpr (SP2) {
        PG8_STAGE(PG8_SB(0, 0), cB, voffB); PG8_STAGE(PG8_SB(0, 1), cB + hstepB, voffB); PG8_STAGE(PG8_SA(0, 0), cA, voffA); PG8_STAGE(PG8_SA(0, 1), cA + hstepA, voffA);
        if (wr == 1) PG8_BAR;
        PG8_WAIT_V(2); PG8_BAR;
        PG8_STAGE(PG8_SB(1, 0), cB + kstep, voffB); PG8_STAGE(PG8_SA(1, 0), cA + kstep, voffA); PG8_STAGE(PG8_SB(1, 1), cB + hstepB + kstep, voffB);
        PG8_WAIT_V(6); PG8_BAR;
    } else {
        PG8_STAGE(PG8_SB(0, 0), cB, voffB); PG8_STAGE(PG8_SA(0, 0), cA, voffA); PG8_STAGE(PG8_SB(0, 1), cB + hstepB, voffB); PG8_STAGE(PG8_SA(0, 1), cA + hstepA, voffA);
        if (wr == 1) PG8_BAR;
        PG8_WAIT_V(4); PG8_BAR;
        PG8_STAGE(PG8_SB(1, 0), cB + kstep, voffB); PG8_STAGE(PG8_SA(1, 0), cA + kstep, voffA); PG8_STAGE(PG8_SB(1, 1), cB + hstepB + kstep, voffB);
        PG8_WAIT_V(6); PG8_BAR;
    }
    for (;;) {
        const bool has_next = S.next(ui + 1, nxt);
        const char* nA = has_next ? (const char*)g.A + (size_t)nxt.pm * tstepA + (size_t)nxt.pn * (size_t)g.a_pn_off * 2 + (size_t)nxt.kb * kstep : cA; const char* nB = has_next ? (const char*)g.Bt + (size_t)nxt.pn * tstepB + (size_t)nxt.kb * kstep : cB;
        const int nt = cur.nkt; const bool full = !cur.half;
        for (int t = 0; t < nt; t += 2) {
            const bool last = (t == nt - 2);
            const char* a1 = cA + (size_t)(t + 1) * kstep;
            const char* a2 = last ? nA : cA + (size_t)(t + 2) * kstep; const char* b2 = last ? nB : cB + (size_t)(t + 2) * kstep;
            const char* a3 = a2 + kstep; const char* b3 = b2 + kstep;
            if (last && has_next) S.a_ready(nxt);
            if constexpr (SP2) {
            const size_t hA = full ? hstepA : 0, hA2 = last ? ((has_next && !nxt.half) ? hstepA : 0) : hA;
            PG8_LDB(B0, 0, 0); PG8_LDB(B1, 0, 1); PG8_SCHED; PG8_LDA(At, 0, 0); PG8_STAGE(PG8_SA(1, 1), a1 + hA, voffA);
            PG8_WAIT_V(8); PG8_WAIT_L(0); PG8_BAR; PG8_MMA(0, 0, At, B0); PG8_MMA(0, 1, At, B1); PG8_BAR; PG8_SCHED;
            if (full) PG8_LDA(At, 0, 1); PG8_STAGE(PG8_SB(0, 0), b2, voffB); PG8_STAGE(PG8_SB(0, 1), b2 + hstepB, voffB); PG8_STAGE(PG8_SA(0, 0), a2, voffA);
            PG8_WAIT_V(8); PG8_WAIT_L(0); PG8_BAR; if (full) { PG8_MMA(1, 0, At, B0); PG8_MMA(1, 1, At, B1); } PG8_BAR; PG8_SCHED;
            PG8_LDB(B0, 1, 0); PG8_LDB(B1, 1, 1); PG8_SCHED; PG8_LDA(At, 1, 0); PG8_STAGE(PG8_SA(0, 1), a2 + hA2, voffA);
            PG8_WAIT_V(8); PG8_WAIT_L(0); PG8_BAR; PG8_MMA(0, 0, At, B0); PG8_MMA(0, 1, At, B1); PG8_BAR; PG8_SCHED;
            if (full) PG8_LDA(At, 1, 1); PG8_STAGE(PG8_SB(1, 0), b3, voffB); PG8_STAGE(PG8_SB(1, 1), b3 + hstepB, voffB); PG8_STAGE(PG8_SA(1, 0), a3, voffA);
            PG8_WAIT_V(8); PG8_WAIT_L(0); PG8_BAR; if (full) { PG8_MMA(1, 0, At, B0); PG8_MMA(1, 1, At, B1); } PG8_BAR; PG8_SCHED;
            } else {
            PG8_LDB(B0, 0, 0); PG8_SCHED; PG8_LDA(At, 0, 0); PG8_STAGE(PG8_SA(1, 1), a1 + hstepA, voffA);
            PG8_WAIT_L(8); PG8_BAR; PG8_WAIT_L(0); PG8_MMA(0, 0, At, B0); PG8_BAR; PG8_SCHED;
            PG8_LDB(B1, 0, 1); PG8_STAGE(PG8_SB(0, 0), b2, voffB);
            PG8_BAR; PG8_WAIT_L(0); PG8_MMA(0, 1, At, B1); PG8_BAR;
            PG8_LDA(At, 0, 1); PG8_STAGE(PG8_SA(0, 0), a2, voffA);
            PG8_BAR; PG8_WAIT_L(0); if (full) PG8_MMA(1, 0, At, B0); PG8_BAR; PG8_SCHED;
            PG8_STAGE(PG8_SB(0, 1), b2 + hstepB, voffB);
            PG8_WAIT_V(6); PG8_BAR; if (full) PG8_MMA(1, 1, At, B1); PG8_BAR;
            PG8_LDB(B0, 1, 0); PG8_SCHED; PG8_LDA(At, 1, 0); PG8_STAGE(PG8_SA(0, 1), a2 + hstepA, voffA);
            PG8_WAIT_L(8); PG8_BAR; PG8_WAIT_L(0); PG8_MMA(0, 0, At, B0); PG8_BAR; PG8_SCHED;
            PG8_LDB(B1, 1, 1); PG8_STAGE(PG8_SB(1, 0), b3, voffB);
            PG8_BAR; PG8_WAIT_L(0); PG8_MMA(0, 1, At, B1); PG8_BAR;
            PG8_LDA(At, 1, 1); PG8_STAGE(PG8_SA(1, 0), a3, voffA);
            PG8_BAR; PG8_WAIT_L(0); if (full) PG8_MMA(1, 0, At, B0); PG8_BAR; PG8_SCHED;
            PG8_STAGE(PG8_SB(1, 1), b3 + hstepB, voffB);
            PG8_WAIT_V(6); PG8_BAR; if (full) PG8_MMA(1, 1, At, B1); PG8_BAR;
            }
        }
        if constexpr (ALIGN_EPI) { if (wr == 0) PG8_BAR; }
        E(acc, cur, wr, wc, fr, fq); S.done(cur);
        if (!has_next) break;
#pragma unroll
        for (int a = 0; a < 2; ++a)
#pragma unroll
            for (int b = 0; b < 2; ++b)
#pragma unroll
                for (int m = 0; m < 4; ++m)
#pragma unroll
                    for (int n = 0; n < 2; ++n) acc[a][b][m][n] = (f32x4){0.f, 0.f, 0.f, 0.f};
        cur = nxt; cA = nA; cB = nB; ++ui;
        if constexpr (ALIGN_EPI) { if (wr == 1) PG8_BAR; }
    }
    PG8_WAIT_V(0);
    if constexpr (!ALIGN_EPI) { if (wr == 0) PG8_BAR; }
    PG8_BAR;
#undef PG8_SA
#undef PG8_SB
#undef PG8_STAGE
#undef PG8_LDA
#undef PG8_LDB
#undef PG8_MMA
#undef PG8_WAIT_V
#undef PG8_WAIT_L
#undef PG8_BAR
#undef PG8_SCHED
}
}

constexpr int NWAVES = 8;
constexpr int NPHASES = 12;
constexpr int D = 4096, TP = 8192, SEQ = 2048, NS = 128, MT = 8320, MP = 8448, NCOND = 132, NMOD = 24576;
constexpr int DIN = 10256, ZW = 10240, DPOOL = 1024, DKT = 1536, DVT = 3072, DKH = 384, DVH = 768, DFF = 11008;
constexpr int ZC_Q = 1024, ZC_K = 2560, ZC_V = 4096, ZC_G = 7168;
constexpr float EPS = 1e-6f;
constexpr float QSCALE = 0.05103103630798288f;
constexpr size_t OFF_POOLP = (size_t)MT * D, OFF_GLAP = OFF_POOLP + 61440, OFF_POOLS = OFF_GLAP + 4718592, OFF_GLAS = OFF_POOLS + 1966080;

constexpr size_t al256(size_t x) { return (x + 255) & ~(size_t)255; }
constexpr size_t WS_CTL = 0, CTL_REGION = 1u << 20, CTL_ZERO_BYTES = 40960;
constexpr size_t WS_MOD = CTL_REGION;
constexpr size_t WS_SC = WS_MOD + al256((size_t)NCOND * NMOD * 4);
constexpr size_t WS_WIN = WS_SC + al256((size_t)144 * D * 2);
constexpr size_t WS_WA = WS_WIN + al256((size_t)ZW * D * 2);
constexpr size_t WS_WOUT = WS_WA + al256((size_t)16 * D * 2);
constexpr size_t WS_W13 = WS_WOUT + al256((size_t)D * D * 2);
constexpr size_t WS_WFF2 = WS_W13 + al256((size_t)2 * DFF * D * 2);
constexpr size_t WS_WP = WS_WFF2 + al256((size_t)D * DFF * 2);
constexpr size_t WS_H = WS_WP + al256((size_t)1024 * 256 * 2);
constexpr size_t WS_Z = WS_H + al256((size_t)MP * D * 2);
constexpr size_t WS_QT = WS_Z + al256((size_t)MP * ZW * 2);
constexpr size_t WS_KT = WS_QT + al256((size_t)TP * DKT * 2);
constexpr size_t WS_EBL = WS_KT + al256((size_t)TP * DKT * 2);
constexpr size_t WS_LAS = WS_EBL + al256((size_t)256 * DKT * 4);
constexpr size_t WS_DP = WS_LAS + al256((size_t)128 * DKT * 4);
constexpr size_t WS_OB = WS_DP + al256((size_t)MP * DPOOL * 2);
constexpr size_t WS_MIX = WS_OB + al256((size_t)MT * DVT * 4);
constexpr size_t WS_X1 = WS_MIX + al256((size_t)MP * D * 2);
constexpr size_t WS_ACT = WS_X1 + al256((size_t)MT * D * 4);
constexpr size_t WS_ZS = WS_ACT + al256((size_t)MP * DFF * 2);
constexpr size_t WS_XS = WS_ZS + al256((size_t)4 * NS * ZW * 4);
constexpr int OV_KS = 8, OV_N = 22, OV_SPLIT = 43, OV_PA = 32, OV_PB = 64, OV_COLS = OV_N * 128;
constexpr size_t WS_SS = WS_XS + al256((size_t)16 * NS * D * 4);
constexpr size_t WS_END = WS_SS + al256((size_t)OV_KS * 2 * NS * OV_COLS * 4);
constexpr int CW_BAR = 4096, CW_Q = 8192;

constexpr int SCRATCH_BYTES = 151552;
constexpr int MISC_OFF = SCRATCH_BYTES;
constexpr int LDS_BYTES = SCRATCH_BYTES + 512;

#define GAS __attribute__((address_space(1)))
#define LAS __attribute__((address_space(3)))
typedef unsigned short bf16;
typedef unsigned v4u __attribute__((ext_vector_type(4)));
typedef unsigned v2u __attribute__((ext_vector_type(2)));
typedef float f32x4 __attribute__((ext_vector_type(4)));
typedef short bf16x8 __attribute__((ext_vector_type(8)));
#define LDS_WAIT() asm volatile("s_waitcnt lgkmcnt(0)" ::: "memory")
__device__ __forceinline__ unsigned f2bf(float f) { unsigned u = __builtin_bit_cast(unsigned, f); return (u + 0x7fffu + ((u >> 16) & 1u)) >> 16; }
__device__ __forceinline__ unsigned pk2(float lo, float hi) { return f2bf(lo) | (f2bf(hi) << 16); }
__device__ __forceinline__ float bflo(unsigned w) { return __builtin_bit_cast(float, w << 16); }
__device__ __forceinline__ float bfhi(unsigned w) { return __builtin_bit_cast(float, w & 0xffff0000u); }
__device__ __forceinline__ float bf2f(bf16 b) { return __builtin_bit_cast(float, ((unsigned)b) << 16); }
__device__ __forceinline__ float silu_acc(float x) { return x / (1.0f + __expf(-x)); }
__device__ __forceinline__ float wave_sum(float v) {
#pragma unroll
    for (int o = 1; o < 64; o <<= 1) v += __shfl_xor(v, o);
    return v;
}

__device__ __forceinline__ int lane_fresh() { int l; asm volatile("v_mbcnt_lo_u32_b32 %0, -1, 0\n\tv_mbcnt_hi_u32_b32 %0, -1, %0" : "=v"(l)); return l; }
#define XB_TMO      128
#define XB_XCNT(j)  (256  + 64 * (j))
#define XB_XSUB(j)  (1280 + 64 * (j))
#define XB_XGEN(j)  (2304 + 64 * (j))
#define XB_TOP      3328
#define XB_TOPGEN   3392
#define XCD_BAR_WORDS 3456
#define XB_SPIN_CAP (1u << 18)

__device__ __forceinline__ unsigned xb_ld(unsigned* p)              { return __hip_atomic_load(p, __ATOMIC_RELAXED, __HIP_MEMORY_SCOPE_AGENT); }
__device__ __forceinline__ unsigned xb_add(unsigned* p, unsigned v) { return __hip_atomic_fetch_add(p, v, __ATOMIC_RELAXED, __HIP_MEMORY_SCOPE_AGENT); }
__device__ __forceinline__ unsigned xb_xcc_id() { return (unsigned)__builtin_amdgcn_s_getreg((3 << 11) | 20) & 0xFu; }
#define XB_SPIN(cond, bar) do { unsigned _sp = 0; while (cond) { __builtin_amdgcn_s_sleep(1); \
    if ((++_sp & 255u) == 0u) { if (xb_ld(&(bar)[XB_TMO])) break; if (_sp > XB_SPIN_CAP) { atomicAdd(&(bar)[XB_TMO], 1u); break; } } } } while (0)

struct XcdBarrier {
    unsigned* bar; unsigned x;
    volatile LAS unsigned* st;
};
__device__ __forceinline__ XcdBarrier xcd_barrier_post(unsigned* bar, volatile LAS unsigned* st) {
    XcdBarrier b; b.bar = bar; b.x = xb_xcc_id(); b.st = st;
    if (threadIdx.x == 0) (void)xb_add(&bar[XB_XCNT(b.x)], 1u);
    return b;
}
__device__ __forceinline__ void xcd_barrier_complete(unsigned* bar, unsigned x, unsigned& nloc, unsigned& nx) {
    const unsigned G = gridDim.x * gridDim.y * gridDim.z;
    unsigned sum, cnt, mine, sp = 0u;
    for (;;) {
        sum = 0u; cnt = 0u; mine = 0u;
#pragma unroll
        for (unsigned j = 0; j < 16; ++j) { const unsigned c = xb_ld(&bar[XB_XCNT(j)]); sum += c; cnt += (c > 0u) ? 1u : 0u; mine = (j == x) ? c : mine; }
        if (sum == G) break;
        __builtin_amdgcn_s_sleep(1);
        if ((++sp & 255u) == 0u) { if (xb_ld(&bar[XB_TMO])) break; if (sp > XB_SPIN_CAP) { atomicAdd(&bar[XB_TMO], 1u); break; } }
    }
    nloc = mine > 0u ? mine : 1u; nx = cnt > 0u ? cnt : 1u;
}
__device__ __forceinline__ void xcd_barrier(const XcdBarrier& b) {
    asm volatile("s_waitcnt vmcnt(0)" ::: "memory");
    __syncthreads();
    if (threadIdx.x == 0) {
        unsigned* bar = b.bar;
        __builtin_amdgcn_s_waitcnt(0);
        unsigned nloc = b.st[0], nx = b.st[1];
        if (nloc == 0u) { xcd_barrier_complete(bar, b.x, nloc, nx); b.st[0] = nloc; b.st[1] = nx; }
        const unsigned old = xb_add(&bar[XB_XSUB(b.x)], 1u);
        const unsigned gen = old / nloc;
        if (old + 1u == (gen + 1u) * nloc) {
            __builtin_amdgcn_fence(__ATOMIC_RELEASE, "agent");
            asm volatile("s_waitcnt vmcnt(0)" ::: "memory");
            const unsigned og = xb_add(&bar[XB_TOP], 1u);
            const unsigned tg = og / nx;
            if (og + 1u == (tg + 1u) * nx) xb_add(&bar[XB_TOPGEN], 1u);
            else XB_SPIN(xb_ld(&bar[XB_TOPGEN]) == tg, bar);
            __builtin_amdgcn_fence(__ATOMIC_ACQUIRE, "agent");
            xb_add(&bar[XB_XGEN(b.x)], 1u);
            asm volatile("s_waitcnt vmcnt(0)" ::: "memory");
        } else {
            XB_SPIN(xb_ld(&bar[XB_XGEN(b.x)]) == gen, bar);
            __builtin_amdgcn_fence(__ATOMIC_ACQUIRE, "agent");
            asm volatile("s_waitcnt vmcnt(0)" ::: "memory");
        }
    }
    __syncthreads();
}

struct Ctx {
    const float *x_prompt, *x_sample, *state_pool, *state_gla, *c_prompt, *c_sample, *w_ada, *b_ada, *g_norm1, *w_in, *w_pool, *pool_scale, *w_a2, *b_a, *g_gla_out,
                *w_out, *g_norm2, *w_ff1, *w_ff3, *w_ff2, *g_final;
    float* out;
    float* MOD; bf16* SC; bf16 *WinT, *WaT, *WoutT, *W13T, *Wff2T, *WpT; bf16 *H, *Z, *QT, *KT; float *EBL, *LAS_; bf16* DP; bf16* OB; bf16* MIX; float* X1; bf16 *X1B, *OPB; bf16* ACT; float *ZS, *XS, *SS;
    LAS unsigned char* lds; int wave, G, gw, NGW;
};

__device__ __forceinline__ void tr_item(const float* W, int ldw, bf16* WT, int ldt, int k0, int n0, int drow0, LAS float* scr, int lane) {
    const int c4 = lane & 15, r4 = lane >> 4;
    const float* wp = W + (size_t)(k0 + r4) * ldw + n0 + 4 * c4;
#pragma unroll
    for (int hh = 0; hh < 2; ++hh) { f32x4 v[8];
#pragma unroll
        for (int i = 0; i < 8; ++i) { v[i] = *(const f32x4*)wp; wp += (size_t)4 * ldw; }
#pragma unroll
        for (int i = 0; i < 8; ++i) { LAS float* s = scr + (4 * (8 * hh + i) + r4) * 65 + 4 * c4; s[0] = v[i].x; s[1] = v[i].y; s[2] = v[i].z; s[3] = v[i].w; } }
    LDS_WAIT(); asm volatile("" ::: "memory");
    const int c = lane & 7;
#pragma unroll
    for (int j = 0; j < 8; ++j) { const int n = (lane >> 3) + 8 * j; const LAS float* s = scr + (8 * c) * 65 + n;
        v4u o; o.x = pk2(s[0 * 65], s[1 * 65]); o.y = pk2(s[2 * 65], s[3 * 65]); o.z = pk2(s[4 * 65], s[5 * 65]); o.w = pk2(s[6 * 65], s[7 * 65]);
        *(v4u*)(WT + (size_t)(drow0 + n) * ldt + k0 + 8 * c) = o; }
    LDS_WAIT(); asm volatile("" ::: "memory");
}
constexpr int I_IN = 64 * 160, I_OUT = 64 * 64, I_F1 = 64 * 172, I_F2 = 172 * 64, I_P = 64;
constexpr int N_TR_ITEMS = I_IN + I_OUT + 2 * I_F1 + I_F2 + I_P;
struct TrItem { const GAS float* W; GAS bf16* WT; int ldw, ldt, k0, n0, drow0; };
__device__ __forceinline__ TrItem tr_params(const Ctx& C, int it) {
    constexpr int B0 = I_IN, B1 = B0 + I_OUT, B2 = B1 + I_F1, B3 = B2 + I_F1, B4 = B3 + I_F2;
    const bool m0 = it < B0, m1 = !m0 && it < B1, m2 = it >= B1 && it < B2, m3 = it >= B2 && it < B3, m4 = it >= B3 && it < B4, m5 = it >= B4;
    int r = it - (m1 ? B0 : 0) - (m2 ? B1 : 0) - (m3 ? B2 : 0) - (m4 ? B3 : 0) - (m5 ? B4 : 0);
    const int g = m5 ? (r >> 4) : 0; r = m5 ? (r & 15) : r;
    const int nbd = (m0 ? 160 : 0) + ((m1 || m4) ? 64 : 0) + ((m2 || m3) ? 172 : 0) + (m5 ? 4 : 0);
    const int kb = r / nbd, nb = r - kb * nbd;
    typedef unsigned long long u64;
    const u64 wsel = ((u64)C.w_in & (u64)-(long long)m0) | ((u64)C.w_out & (u64)-(long long)m1) | ((u64)C.w_ff1 & (u64)-(long long)m2) | ((u64)C.w_ff3 & (u64)-(long long)m3) | ((u64)C.w_ff2 & (u64)-(long long)m4) | ((u64)C.w_pool & (u64)-(long long)m5);
    const u64 tsel = ((u64)C.WinT & (u64)-(long long)m0) | ((u64)C.WoutT & (u64)-(long long)m1) | ((u64)C.W13T & (u64)-(long long)(m2 || m3)) | ((u64)C.Wff2T & (u64)-(long long)m4) | ((u64)C.WpT & (u64)-(long long)m5);
    TrItem T;
    T.W = (const GAS float*)wsel + (size_t)g * 65536;
    T.WT = (GAS bf16*)tsel + (size_t)g * 65536;
    T.ldw = (m0 ? DIN : 0) + ((m1 || m4) ? D : 0) + ((m2 || m3) ? DFF : 0) + (m5 ? 256 : 0);
    T.ldt = m4 ? DFF : (m5 ? 256 : D);
    T.k0 = 64 * kb; T.n0 = 64 * nb;
    T.drow0 = (m2 || m3) ? ((T.n0 >> 7) * 256 + (T.n0 & 127) + (m3 ? 128 : 0)) : T.n0;
    return T;
}
__device__ __forceinline__ void tr_dispatch(const Ctx& C, int it, LAS float* scr, int lane) {
    const TrItem T = tr_params(C, it);
    tr_item((const float*)T.W, T.ldw, (bf16*)T.WT, T.ldt, T.k0, T.n0, T.drow0, scr, lane);
}
__device__ __forceinline__ void p0_small(const Ctx& C) {
    const int lane = lane_fresh();
    for (int i = C.gw * 64 + lane; i < 16 * D; i += C.NGW * 64) { const int r = i >> 12, k = i & 4095; C.WaT[i] = (bf16)f2bf(C.w_in[(size_t)k * DIN + ZW + r]); }
    for (int i = C.gw * 64 + lane; i < 144 * D; i += C.NGW * 64) { const int m = i >> 12, k = i & 4095; float v = 0.f;
        if (m < 4) v = silu_acc(C.c_prompt[m * D + k]); else if (m < NCOND) v = silu_acc(C.c_sample[(m - 4) * D + k]);
        C.SC[i] = (bf16)f2bf(v); }
}

struct __attribute__((packed, aligned(4))) F3 { float x, y, z; };
template <bool TR>
__device__ __forceinline__ void p1_kstep(const Ctx& C, f32x4 (&acc)[9][3], const __amdgpu_buffer_rsrc_t rB, const __amdgpu_buffer_rsrc_t rA, int& sB, int& sA, int tr_it, LAS float* scr) {
    const int lane = lane_fresh();
    const unsigned boff = (unsigned)((8 * (lane >> 4)) * NMOD + 3 * (lane & 15)) * 4u, aoff = (unsigned)((lane & 15) * D + 8 * (lane >> 4)) * 2u;
    typedef decltype(__builtin_amdgcn_raw_buffer_load_b96(rB, 0u, 0, 0)) ld3_t; typedef decltype(__builtin_amdgcn_raw_buffer_load_b128(rA, 0u, 0, 0)) ld4_t;
#define P1_F(u_) __uint_as_float((unsigned)(u_))
    const int c4 = lane & 15, r4 = lane >> 4;
    TrItem T; const GAS float* wp = nullptr; f32x4 tv[8];
    if constexpr (TR) { T = tr_params(C, tr_it); wp = T.W + (size_t)(T.k0 + r4) * T.ldw + T.n0 + 4 * c4;
#pragma unroll
        for (int i = 0; i < 8; ++i) { tv[i] = *(const GAS f32x4*)wp; wp += (size_t)4 * T.ldw; } }
    __builtin_amdgcn_sched_barrier(0);
    ld3_t RW[8]; ld4_t AF[9];
#pragma unroll
    for (int j = 0; j < 8; ++j) RW[j] = __builtin_amdgcn_raw_buffer_load_b96(rB, boff, sB + j * NMOD * 4, 0);
    sB += 32 * NMOD * 4;
    __builtin_amdgcn_sched_barrier(0);
    if constexpr (!TR) {
#pragma unroll
        for (int mt = 0; mt < 9; ++mt) AF[mt] = __builtin_amdgcn_raw_buffer_load_b128(rA, aoff, sA + 16 * mt * D * 2, 0);
    }
    if constexpr (TR) {
#pragma unroll
        for (int i = 0; i < 8; ++i) { LAS float* s = scr + (4 * i + r4) * 65 + 4 * c4; s[0] = tv[i].x; s[1] = tv[i].y; s[2] = tv[i].z; s[3] = tv[i].w; }
        __builtin_amdgcn_sched_barrier(0);
#pragma unroll
        for (int i = 0; i < 8; ++i) { tv[i] = *(const GAS f32x4*)wp; wp += (size_t)4 * T.ldw; }
        __builtin_amdgcn_sched_barrier(0);
#pragma unroll
        for (int i = 0; i < 8; ++i) { LAS float* s = scr + (4 * (8 + i) + r4) * 65 + 4 * c4; s[0] = tv[i].x; s[1] = tv[i].y; s[2] = tv[i].z; s[3] = tv[i].w; }
        __builtin_amdgcn_sched_barrier(0);
#pragma unroll
        for (int mt = 0; mt < 9; ++mt) AF[mt] = __builtin_amdgcn_raw_buffer_load_b128(rA, aoff, sA + 16 * mt * D * 2, 0);
        __builtin_amdgcn_sched_barrier(0);
        LDS_WAIT(); asm volatile("" ::: "memory");
        const int c = lane & 7;
#pragma unroll
        for (int j = 0; j < 8; ++j) { const int n = (lane >> 3) + 8 * j; const LAS float* s = scr + (8 * c) * 65 + n;
            v4u o; o.x = pg8::cvt_pk_bf16(s[0 * 65], s[1 * 65]); o.y = pg8::cvt_pk_bf16(s[2 * 65], s[3 * 65]); o.z = pg8::cvt_pk_bf16(s[4 * 65], s[5 * 65]); o.w = pg8::cvt_pk_bf16(s[6 * 65], s[7 * 65]);
            *(GAS v4u*)(T.WT + (size_t)(T.drow0 + n) * T.ldt + T.k0 + 8 * c) = o; }
        LDS_WAIT(); asm volatile("" ::: "memory");
    }
    sA += 64;
    v4u b0, b1, b2;
    b0.x = pg8::cvt_pk_bf16(P1_F(RW[0][0]), P1_F(RW[1][0])); b0.y = pg8::cvt_pk_bf16(P1_F(RW[2][0]), P1_F(RW[3][0])); b0.z = pg8::cvt_pk_bf16(P1_F(RW[4][0]), P1_F(RW[5][0])); b0.w = pg8::cvt_pk_bf16(P1_F(RW[6][0]), P1_F(RW[7][0]));
    b1.x = pg8::cvt_pk_bf16(P1_F(RW[0][1]), P1_F(RW[1][1])); b1.y = pg8::cvt_pk_bf16(P1_F(RW[2][1]), P1_F(RW[3][1])); b1.z = pg8::cvt_pk_bf16(P1_F(RW[4][1]), P1_F(RW[5][1])); b1.w = pg8::cvt_pk_bf16(P1_F(RW[6][1]), P1_F(RW[7][1]));
    b2.x = pg8::cvt_pk_bf16(P1_F(RW[0][2]), P1_F(RW[1][2])); b2.y = pg8::cvt_pk_bf16(P1_F(RW[2][2]), P1_F(RW[3][2])); b2.z = pg8::cvt_pk_bf16(P1_F(RW[4][2]), P1_F(RW[5][2])); b2.w = pg8::cvt_pk_bf16(P1_F(RW[6][2]), P1_F(RW[7][2]));
    const bf16x8 B0 = __builtin_bit_cast(bf16x8, b0), B1 = __builtin_bit_cast(bf16x8, b1), B2 = __builtin_bit_cast(bf16x8, b2);
#pragma unroll
    for (int mt = 0; mt < 9; ++mt) { const bf16x8 a_ = __builtin_bit_cast(bf16x8, AF[mt]);
        acc[mt][0] = __builtin_amdgcn_mfma_f32_16x16x32_bf16(a_, B0, acc[mt][0], 0, 0, 0);
        acc[mt][1] = __builtin_amdgcn_mfma_f32_16x16x32_bf16(a_, B1, acc[mt][1], 0, 0, 0);
        acc[mt][2] = __builtin_amdgcn_mfma_f32_16x16x32_bf16(a_, B2, acc[mt][2], 0, 0, 0); }
#undef P1_F
}
__device__ __forceinline__ void p1_adaln(const Ctx& C) {
    const int w = C.wave, sub = w & 1, kq = w >> 1;
    LAS f32x4* slab = (LAS f32x4*)C.lds;
    LAS float* scr = (LAS float*)(C.lds + w * 16640);
    int tr_it = C.gw;
    const __amdgpu_buffer_rsrc_t rB = __builtin_amdgcn_make_buffer_rsrc((void*)C.w_ada, 0, (int)((size_t)D * NMOD * 4), 0x00020000);
    const __amdgpu_buffer_rsrc_t rA = __builtin_amdgcn_make_buffer_rsrc((void*)C.SC, 0, 144 * D * 2, 0x00020000);
    for (int cg = blockIdx.x; cg < 256; cg += C.G) {
        const int n0 = 96 * cg + 48 * sub, kbase = 1024 * kq;
        f32x4 acc[9][3];
#pragma unroll
        for (int mt = 0; mt < 9; ++mt)
#pragma unroll
            for (int i = 0; i < 3; ++i) acc[mt][i] = (f32x4){0.f, 0.f, 0.f, 0.f};
        int sB = (kbase * NMOD + n0) * 4, sA = kbase * 2;
        int ks = 0;
#if TR_SPREAD
        const int ntr = tr_it < N_TR_ITEMS ? (N_TR_ITEMS - tr_it + C.NGW - 1) / C.NGW : 0, ntc = ntr < 32 ? ntr : 32;
#pragma unroll 1
        for (; ks < 32; ++ks) {
            if (((ks + 1) * ntc) / 32 > (ks * ntc) / 32) { p1_kstep<true>(C, acc, rB, rA, sB, sA, tr_it, scr); tr_it += C.NGW; }
            else p1_kstep<false>(C, acc, rB, rA, sB, sA, 0, scr);
        }
#else
#pragma unroll 1
        for (; ks < 32 && tr_it < N_TR_ITEMS; ++ks) { p1_kstep<true>(C, acc, rB, rA, sB, sA, tr_it, scr); tr_it += C.NGW; }
#pragma unroll 1
        for (; ks < 32; ++ks) p1_kstep<false>(C, acc, rB, rA, sB, sA, 0, scr);
#endif
        __syncthreads();
        { const int lane = lane_fresh(), c = lane & 15, g = lane >> 4;
        if (w >= 4) {
#pragma unroll
            for (int q = 0; q < 27; ++q) slab[(w - 4) * 27 * 64 + q * 64 + lane] = acc[q / 3][q % 3];
        }
        __syncthreads();
        if (w < 4) {
#pragma unroll
            for (int q = 0; q < 27; ++q) { acc[q / 3][q % 3] += slab[w * 27 * 64 + q * 64 + lane]; if ((q % 3) == 2) asm volatile("" ::: "memory"); }
            if (w >= 2) {
#pragma unroll
                for (int q = 0; q < 27; ++q) slab[w * 27 * 64 + q * 64 + lane] = acc[q / 3][q % 3];
            }
        }
        __syncthreads();
        if (w < 2) {
#pragma unroll
            for (int q = 0; q < 27; ++q) { acc[q / 3][q % 3] += slab[(w + 2) * 27 * 64 + q * 64 + lane]; if ((q % 3) == 2) asm volatile("" ::: "memory"); }
            const float bb0 = C.b_ada[n0 + 3 * c], bb1 = C.b_ada[n0 + 3 * c + 1], bb2 = C.b_ada[n0 + 3 * c + 2];
            int g2 = g; asm volatile("" : "+v"(g2));
            GAS float* o = (GAS float*)C.MOD + (size_t)(4 * g2) * NMOD + n0 + 3 * c;
#pragma unroll
            for (int mt = 0; mt < 9; ++mt) {
#pragma unroll
                for (int r = 0; r < 4; ++r) { const int m = 16 * mt + 4 * g2 + r;
                    if (m < NCOND) { o[0] = acc[mt][0][r] + bb0; o[1] = acc[mt][1][r] + bb1; o[2] = acc[mt][2][r] + bb2; }
                    o += NMOD; asm volatile("" : "+v"(o)); }
                o += 12 * NMOD; }
        }
        }
        __syncthreads();
    }
    for (; tr_it < N_TR_ITEMS; tr_it += C.NGW) tr_dispatch(C, tr_it, scr, lane_fresh());
}

template <int NSL>
__device__ __forceinline__ void sample_row_from_slabs(const float* base, const float* gate, const float* slabs, int n, f32x4 (&v)[2], float& ssq, LAS float* lds_red, int t, int w) {
#pragma unroll
    for (int j = 0; j < 2; ++j) { const int c = 4 * t + 2048 * j;
        f32x4 a = *(const f32x4*)(slabs + ((size_t)0 * NS + n) * D + c);
#pragma unroll
        for (int k = 1; k < NSL; ++k) a += *(const f32x4*)(slabs + ((size_t)k * NS + n) * D + c);
        v[j] = *(const f32x4*)(base + c) + *(const f32x4*)(gate + c) * a; }
    float s = (v[0].x * v[0].x + v[0].y * v[0].y) + (v[0].z * v[0].z + v[0].w * v[0].w) + (v[1].x * v[1].x + v[1].y * v[1].y) + (v[1].z * v[1].z + v[1].w * v[1].w);
    s = wave_sum(s);
    __syncthreads();
    if ((t & 63) == 0) lds_red[w] = s;
    __syncthreads();
    ssq = 0.f;
#pragma unroll
    for (int ww = 0; ww < 8; ++ww) ssq += lds_red[ww];
}

template <bool X16>
__device__ __forceinline__ void norm_rows(const Ctx& C, const float* xa, const bf16* xa16, const float* xb, const float* gain, int sh_off, int sc_off, bf16* Hout, const float* slabs, int gate_off, float* x1s) {
    const int lane = lane_fresh();
    auto do_row = [&](int row) {
        v2u* o = (v2u*)(Hout + (size_t)row * D) + lane;
        if (row >= MT) {
#pragma unroll
            for (int j = 0; j < 16; ++j) o[64 * j] = (v2u){0u, 0u};
            return;
        }
        if (slabs != nullptr && row >= TP) return;
        if (X16 && row < TP) {
            const v4u* xv = (const v4u*)(xa16 + (size_t)row * D) + lane;
            v4u w[8]; float s = 0.f;
#pragma unroll
            for (int j = 0; j < 8; ++j) w[j] = xv[64 * j];
#pragma unroll
            for (int j = 0; j < 8; ++j) { const float a0 = bflo(w[j].x), a1 = bfhi(w[j].x), a2 = bflo(w[j].y), a3 = bfhi(w[j].y), a4 = bflo(w[j].z), a5 = bfhi(w[j].z), a6 = bflo(w[j].w), a7 = bfhi(w[j].w);
                s += ((a0 * a0 + a1 * a1) + (a2 * a2 + a3 * a3)) + ((a4 * a4 + a5 * a5) + (a6 * a6 + a7 * a7)); }
            const float rstd = 1.0f / sqrtf(wave_sum(s) * (1.0f / D) + EPS);
            const float* md = C.MOD + (size_t)(row >> 11) * NMOD;
            v4u* ob = (v4u*)(Hout + (size_t)row * D) + lane;
#pragma unroll
            for (int j = 0; j < 8; ++j) { const int c = 8 * (64 * j + lane);
                const f32x4 g0 = *(const f32x4*)(gain + c), g1 = *(const f32x4*)(gain + c + 4), sh0 = *(const f32x4*)(md + sh_off + c), sh1 = *(const f32x4*)(md + sh_off + c + 4);
                const f32x4 sc0 = *(const f32x4*)(md + sc_off + c), sc1 = *(const f32x4*)(md + sc_off + c + 4);
                const f32x4 x0 = (f32x4){bflo(w[j].x), bfhi(w[j].x), bflo(w[j].y), bfhi(w[j].y)}, x1 = (f32x4){bflo(w[j].z), bfhi(w[j].z), bflo(w[j].w), bfhi(w[j].w)};
                const f32x4 h0 = x0 * rstd * g0 * (sc0 + 1.0f) + sh0, h1 = x1 * rstd * g1 * (sc1 + 1.0f) + sh1;
                ob[64 * j] = (v4u){pk2(h0.x, h0.y), pk2(h0.z, h0.w), pk2(h1.x, h1.y), pk2(h1.z, h1.w)}; }
            return;
        }
        const float* xr = row < TP ? xa + (size_t)row * D : xb + (size_t)(row - TP) * D;
        const int ci = row < TP ? (row >> 11) : (4 + row - TP);
        const f32x4* xv = (const f32x4*)xr + lane;
        f32x4 v[16]; float s = 0.f;
#pragma unroll
        for (int j = 0; j < 16; ++j) { v[j] = xv[64 * j]; s += (v[j].x * v[j].x + v[j].y * v[j].y) + (v[j].z * v[j].z + v[j].w * v[j].w); }
        const float rstd = 1.0f / sqrtf(wave_sum(s) * (1.0f / D) + EPS);
        const f32x4* gv = (const f32x4*)gain + lane;
        const f32x4* shv = (const f32x4*)(C.MOD + (size_t)ci * NMOD + sh_off) + lane;
        const f32x4* scv = (const f32x4*)(C.MOD + (size_t)ci * NMOD + sc_off) + lane;
#pragma unroll
        for (int j = 0; j < 16; ++j) { const f32x4 gg = gv[64 * j], sh = shv[64 * j], sc = scv[64 * j];
            const f32x4 h = v[j] * rstd * gg * (sc + 1.0f) + sh;
            o[64 * j] = (v2u){pk2(h.x, h.y), pk2(h.z, h.w)}; }
    };
    for (int bi = (int)blockIdx.x; bi < TP / 32; bi += C.G)
#pragma unroll 1
        for (int k = 0; k < 4; ++k) do_row(32 * bi + C.wave + 8 * k);
    for (int n = (int)blockIdx.x; n < MP - TP; n += C.G) if (C.wave == (n & 7)) do_row(TP + n);
    if (slabs != nullptr) {
        const int t = threadIdx.x, w = C.wave;
        for (int n = blockIdx.x; n < NS; n += C.G) {
            const int row = TP + n; const float* md = C.MOD + (size_t)(4 + n) * NMOD;
            f32x4 v[2]; float ssq;
            sample_row_from_slabs<8>(xb + (size_t)n * D, md + gate_off, slabs, n, v, ssq, (LAS float*)C.lds, t, w);
            const float rstd = 1.0f / sqrtf(ssq * (1.0f / D) + EPS);
#pragma unroll
            for (int j = 0; j < 2; ++j) { const int c = 4 * t + 2048 * j;
                *(f32x4*)(x1s + (size_t)row * D + c) = v[j];
                const f32x4 gg = *(const f32x4*)(gain + c), sh = *(const f32x4*)(md + sh_off + c), sc = *(const f32x4*)(md + sc_off + c);
                const f32x4 h = v[j] * rstd * gg * (sc + 1.0f) + sh;
                *(v2u*)(Hout + (size_t)row * D + c) = (v2u){pk2(h.x, h.y), pk2(h.z, h.w)}; }
        }
    }
}

__device__ __forceinline__ float log_sigmoid_f(float x) { return fminf(x, 0.f) - __logf(1.0f + __expf(-fabsf(x))); }
template <int W>
__device__ __forceinline__ void pool_rows32(const Ctx& C, int row0, int t0, int t) {
    const char* zb = (const char*)C.Z + (size_t)row0 * ZW * 2;
    char* db = (char*)C.DP + (size_t)row0 * DPOOL * 2;
    const unsigned vo = 4u * (unsigned)t;
    unsigned u[W - 1 + 32];
#pragma unroll
    for (int k = 0; k < W - 1; ++k) { const int r = t0 - (W - 1) + k; u[k] = (r >= 0) ? *(const unsigned*)(zb - (ptrdiff_t)(W - 1 - k) * ZW * 2 + vo) : 0u; }
#pragma unroll
    for (int i = 0; i < 32; ++i) u[W - 1 + i] = *(const unsigned*)(zb + (size_t)i * ZW * 2 + vo);
    float s0 = 0.f, s1 = 0.f;
#pragma unroll
    for (int k = 0; k < W - 1; ++k) { s0 += bflo(u[k]); s1 += bfhi(u[k]); }
    const bool tail = (t0 + 32 == SEQ);
#pragma unroll
    for (int i = 0; i < 32; ++i) { const unsigned cur = u[W - 1 + i]; const float u0 = bflo(cur), u1 = bfhi(cur);
        s0 += u0; s1 += u1;
        if (i > 0) { s0 -= bflo(u[i - 1]); s1 -= bfhi(u[i - 1]); }
        const int pos = t0 + i; const float inv = 1.0f / (float)(pos + 1 < W ? pos + 1 : W);
        *(unsigned*)(db + (size_t)i * DPOOL * 2 + vo) = pk2(s0 * inv - u0, s1 * inv - u1);
        if (i >= 17 && tail) { float* o = (float*)((char*)(C.out + OFF_POOLP + ((size_t)(row0 / SEQ) * 15 + (i - 17)) * DPOOL) + 2u * vo); o[0] = u0; o[1] = u1; } }
}
__device__ __forceinline__ void p4_prep(const Ctx& C) {
    const int t = threadIdx.x, lane = lane_fresh(), w = C.wave;
    LAS float* part = (LAS float*)C.lds;
    LAS float* alr = (LAS float*)(C.lds + 16384);
    LAS float* sred = (LAS float*)(C.lds + 16384 + 2048);
    LAS float* salr = sred + 128;
    for (int i = blockIdx.x * 512 + t; i < NS * ZW / 4; i += C.G * 512) { const int n = i / (ZW / 4), c4 = i % (ZW / 4);
        f32x4 a = *(const f32x4*)(C.ZS + ((size_t)0 * NS + n) * ZW + 4 * c4);
#pragma unroll
        for (int k = 1; k < 4; ++k) a += *(const f32x4*)(C.ZS + ((size_t)k * NS + n) * ZW + 4 * c4);
        *(v2u*)(C.Z + (size_t)(TP + n) * ZW + 4 * c4) = (v2u){pk2(a.x, a.y), pk2(a.z, a.w)}; }
    for (int ch = blockIdx.x; ch < TP / 32; ch += C.G) {
        const int row0 = 32 * ch;
        {
            const int r = lane & 15, g = lane >> 4;
            f32x4 pa[2] = {(f32x4){0.f, 0.f, 0.f, 0.f}, (f32x4){0.f, 0.f, 0.f, 0.f}};
#pragma unroll 8
            for (int ks = 0; ks < 16; ++ks) { const int k = 512 * w + 32 * ks + 8 * g;
                const bf16x8 bw = *(const bf16x8*)(C.WaT + (size_t)r * D + k);
#pragma unroll
                for (int mt = 0; mt < 2; ++mt) { const bf16x8 a = *(const bf16x8*)(C.H + (size_t)(row0 + 16 * mt + r) * D + k);
                    pa[mt] = __builtin_amdgcn_mfma_f32_16x16x32_bf16(a, bw, pa[mt], 0, 0, 0); } }
#pragma unroll
            for (int mt = 0; mt < 2; ++mt)
#pragma unroll
                for (int q = 0; q < 4; ++q) part[w * 512 + (16 * mt + 4 * g + q) * 16 + r] = pa[mt][q];
        }
        __syncthreads();
        { float sm = 0.f;
#pragma unroll
            for (int ww = 0; ww < 8; ++ww) sm += part[ww * 512 + t];
            alr[t] = sm; }
        __syncthreads();
#pragma unroll 1
        for (int cc = 0; cc < 3; ++cc) { const int c = t + 512 * cc; const unsigned vq = 2u * (unsigned)(ZC_Q + c), vk = 2u * (unsigned)(ZC_K + c), vc = 2u * (unsigned)c;
            float w2[16]; const float ba = C.b_a[c];
#pragma unroll
            for (int r = 0; r < 16; ++r) w2[r] = C.w_a2[r * DKT + c];
            float bc = 0.f;
#pragma unroll 1
            for (int hh = 0; hh < 2; ++hh) {
                const char* zb = (const char*)C.Z + (size_t)(row0 + 16 * hh) * ZW * 2;
                char* qb = (char*)C.QT + (size_t)(row0 + 16 * hh) * DKT * 2; char* kb = (char*)C.KT + (size_t)(row0 + 16 * hh) * DKT * 2;
                bf16 qv[16], kv[16];
#pragma unroll
                for (int i = 0; i < 16; ++i) { qv[i] = *(const bf16*)(zb + (size_t)i * ZW * 2 + vq); kv[i] = *(const bf16*)(zb + (size_t)i * ZW * 2 + vk); }
#pragma unroll
                for (int i = 0; i < 16; ++i) {
                    float x = ba;
#pragma unroll
                    for (int q = 0; q < 4; ++q) { const f32x4 av = *(const LAS f32x4*)(alr + (16 * hh + i) * 16 + 4 * q);
                        x = fmaf(av.x, w2[4 * q], x); x = fmaf(av.y, w2[4 * q + 1], x); x = fmaf(av.z, w2[4 * q + 2], x); x = fmaf(av.w, w2[4 * q + 3], x); }
                    bc += log_sigmoid_f(x) * (1.0f / 16.0f);
                    *(bf16*)(qb + (size_t)i * DKT * 2 + vc) = (bf16)f2bf(bf2f(qv[i]) * QSCALE * __expf(bc));
                    *(bf16*)(kb + (size_t)i * DKT * 2 + vc) = (bf16)f2bf(bf2f(kv[i]) * __expf(-bc));
                }
            }
            C.EBL[(size_t)ch * DKT + c] = __expf(bc);
        }
        { const int t0 = row0 & (SEQ - 1);
            switch (w >> 1) { case 0: pool_rows32<2>(C, row0, t0, t); break; case 1: pool_rows32<4>(C, row0, t0, t); break;
                              case 2: pool_rows32<8>(C, row0, t0, t); break; default: pool_rows32<16>(C, row0, t0, t); break; } }
        __syncthreads();
    }
    for (int n = blockIdx.x; n < NS; n += C.G) {
        const int row = TP + n;
        {
            const v4u hv = *(const v4u*)(C.H + (size_t)row * D + 8 * t);
            const float hf[8] = {bflo(hv.x), bfhi(hv.x), bflo(hv.y), bfhi(hv.y), bflo(hv.z), bfhi(hv.z), bflo(hv.w), bfhi(hv.w)};
#pragma unroll
            for (int r = 0; r < 16; ++r) { const v4u wv = *(const v4u*)(C.WaT + (size_t)r * D + 8 * t);
                float p = hf[0] * bflo(wv.x) + hf[1] * bfhi(wv.x) + hf[2] * bflo(wv.y) + hf[3] * bfhi(wv.y) + hf[4] * bflo(wv.z) + hf[5] * bfhi(wv.z) + hf[6] * bflo(wv.w) + hf[7] * bfhi(wv.w);
                p = wave_sum(p);
                if (lane == 0) sred[w * 16 + r] = p; }
        }
        __syncthreads();
        if (t < 16) { float sm = 0.f;
#pragma unroll
            for (int ww = 0; ww < 8; ++ww) sm += sred[ww * 16 + t];
            salr[t] = sm; }
        __syncthreads();
        float a[16];
#pragma unroll
        for (int q = 0; q < 4; ++q) { const f32x4 av = *(const LAS f32x4*)(salr + 4 * q); a[4 * q] = av.x; a[4 * q + 1] = av.y; a[4 * q + 2] = av.z; a[4 * q + 3] = av.w; }
#pragma unroll
        for (int cc = 0; cc < 3; ++cc) { const int c = t + 512 * cc; float x = C.b_a[c];
#pragma unroll
            for (int r = 0; r < 16; ++r) x = fmaf(a[r], C.w_a2[r * DKT + c], x);
            C.LAS_[(size_t)n * DKT + c] = log_sigmoid_f(x) * (1.0f / 16.0f); }
        __syncthreads();
    }
}

__device__ __forceinline__ void p5_sample_pool(const Ctx& C) {
    const int t = threadIdx.x, w = C.wave;
    for (int n = blockIdx.x; n < NS; n += C.G) {
        const int row = TP + n;
        {
            const int wdw = 2 << (w >> 1); const float inv = 1.0f / (float)wdw;
            const unsigned uu = ((const unsigned*)C.Z)[(size_t)row * (ZW / 2) + t]; const float u0 = bflo(uu), u1 = bfhi(uu);
            const float* sp = C.state_pool + (size_t)n * 15 * DPOOL + 2 * t;
            float* so = C.out + OFF_POOLS + (size_t)n * 15 * DPOOL + 2 * t;
            float s0 = u0, s1 = u1;
#pragma unroll
            for (int r = 0; r < 15; ++r) { const float p0 = sp[(size_t)r * DPOOL], p1 = sp[(size_t)r * DPOOL + 1];
                if (r >= 16 - wdw) { s0 += p0; s1 += p1; }
                if (r >= 1) { so[(size_t)(r - 1) * DPOOL] = p0; so[(size_t)(r - 1) * DPOOL + 1] = p1; } }
            so[(size_t)14 * DPOOL] = u0; so[(size_t)14 * DPOOL + 1] = u1;
            ((unsigned*)C.DP)[(size_t)row * (DPOOL / 2) + t] = pk2(s0 * inv - u0, s1 * inv - u1);
        }
    }
}

__device__ __forceinline__ void p5_gla_sample_q(const Ctx& C, unsigned* qctr) {
    const int t = threadIdx.x, lane = lane_fresh(), w = C.wave;
    LAS float* qs = (LAS float*)C.lds; LAS float* ks = qs + 384; LAS float* as = ks + 384;
    LAS float* opart = (LAS float*)(C.lds + 8192);
    volatile LAS unsigned* itw = (volatile LAS unsigned*)(C.lds + 8192 + 8192);
    if (t == 0) itw[0] = atomicAdd(qctr, 1u);
    __syncthreads();
    for (int par = 0;; par ^= 1) {
        const int it = (int)itw[par];
        if (it >= NS * 12) break;
        if (t == 0) itw[par ^ 1] = atomicAdd(qctr, 1u);
        const int n = it / 12, r12 = it % 12, h = r12 / 3, et = r12 % 3, row = TP + n;
        if (t < DKH) { qs[t] = bf2f(C.Z[(size_t)row * ZW + ZC_Q + h * DKH + t]) * QSCALE; ks[t] = bf2f(C.Z[(size_t)row * ZW + ZC_K + h * DKH + t]);
            as[t] = __expf(C.LAS_[(size_t)n * DKT + h * DKH + t]); }
        const v2u vv = *(const v2u*)(C.Z + (size_t)row * ZW + ZC_V + h * DVH + 256 * et + 4 * lane);
        const f32x4 v = (f32x4){bflo(vv.x), bfhi(vv.x), bflo(vv.y), bfhi(vv.y)};
        f32x4 o = (f32x4){0.f, 0.f, 0.f, 0.f};
        const float* S0 = C.state_gla + ((size_t)(n * 4 + h) * DKH + w) * DVH + 256 * et + 4 * lane;
        float* S1 = C.out + OFF_GLAS + ((size_t)(n * 4 + h) * DKH + w) * DVH + 256 * et + 4 * lane;
        f32x4 ra[16], rb[16];
#pragma unroll
        for (int i = 0; i < 16; ++i) ra[i] = __builtin_nontemporal_load((const f32x4*)(S0 + (size_t)(8 * i) * DVH));
#pragma unroll
        for (int i = 0; i < 16; ++i) rb[i] = __builtin_nontemporal_load((const f32x4*)(S0 + (size_t)(8 * (16 + i)) * DVH));
        __syncthreads();
#pragma unroll
        for (int i = 0; i < 16; ++i) { const int d = w + 8 * i; const f32x4 sn = ra[i] * as[d] + v * ks[d];
            __builtin_nontemporal_store(sn, (f32x4*)(S1 + (size_t)(8 * i) * DVH)); o += sn * qs[d]; }
#pragma unroll
        for (int i = 0; i < 16; ++i) ra[i] = __builtin_nontemporal_load((const f32x4*)(S0 + (size_t)(8 * (32 + i)) * DVH));
#pragma unroll
        for (int i = 0; i < 16; ++i) { const int d = w + 8 * (16 + i); const f32x4 sn = rb[i] * as[d] + v * ks[d];
            __builtin_nontemporal_store(sn, (f32x4*)(S1 + (size_t)(8 * (16 + i)) * DVH)); o += sn * qs[d]; }
#pragma unroll
        for (int i = 0; i < 16; ++i) { const int d = w + 8 * (32 + i); const f32x4 sn = ra[i] * as[d] + v * ks[d];
            __builtin_nontemporal_store(sn, (f32x4*)(S1 + (size_t)(8 * (32 + i)) * DVH)); o += sn * qs[d]; }
        *(LAS f32x4*)(opart + w * 256 + 4 * lane) = o;
        __syncthreads();
        if (t < 256) { float sum = 0.f;
#pragma unroll
            for (int ww = 0; ww < 8; ++ww) sum += opart[ww * 256 + t];
            C.OB[(size_t)row * DVT + h * DVH + 256 * et + t] = (bf16)f2bf(sum); }
        __syncthreads();
    }
}

constexpr int GL_QL = 0, GL_KL = 24576, GL_KT = 49152, GL_VT = 76800, GL_P = 81408, GL_OS = 83712;
__device__ __forceinline__ bf16x8 mk_frag(v2u lo, v2u hi) { v4u x; x.x = lo.x; x.y = lo.y; x.z = hi.x; x.w = hi.y; return __builtin_bit_cast(bf16x8, x); }
__device__ __forceinline__ void p5_gla_prompt(const Ctx& C) {
    const int t = threadIdx.x, lane = lane_fresh(), w = C.wave, c = lane & 15, g = lane >> 4, dg = w >> 1, eh = w & 1;
    LAS unsigned char* L = C.lds;
    for (int item = blockIdx.x; item < 192; item += C.G) {
        const int bh = 2 * (item & 7) + ((item >> 3) / 12), es = (item >> 3) % 12, h = bh & 3, b = bh >> 2;
        const bf16* qg = C.QT + (size_t)(b * SEQ) * DKT + h * DKH;
        const bf16* kg = C.KT + (size_t)(b * SEQ) * DKT + h * DKH;
        const bf16* vg = C.Z + (size_t)(b * SEQ) * ZW + ZC_V + h * DVH + 64 * es;
        const int q_row[3] = {t / 48, (t + 512) / 48, (t + 1024) / 48}, q_ch[3] = {t % 48, (t + 512) % 48, (t + 1024) % 48};
        const int k_rp = t & 15, k_ch0 = t >> 4, k_ch1 = (t >> 4) + 32;
        const int v_rp = t & 15, v_ch = t >> 4;
        f32x4 R[3][2][2];
#pragma unroll
        for (int p = 0; p < 3; ++p)
#pragma unroll
            for (int hf = 0; hf < 2; ++hf)
#pragma unroll
                for (int et = 0; et < 2; ++et) R[p][hf][et] = (f32x4){0.f, 0.f, 0.f, 0.f};
        if (t < 128) { const int i = t >> 3, q = t & 7; *(LAS unsigned*)(L + GL_P + i * 72 + 32 + 4 * q) = 0u; }
        v4u pq[3], pk[4], pv[2];
        const unsigned qo0 = (unsigned)(q_row[0] * DKT + 8 * q_ch[0]) * 2u, qo1 = (unsigned)(q_row[1] * DKT + 8 * q_ch[1]) * 2u, qo2 = (unsigned)(q_row[2] * DKT + 8 * q_ch[2]) * 2u;
        const unsigned ko0 = (unsigned)(2 * k_rp * DKT + 8 * k_ch0) * 2u, ko1 = (unsigned)(2 * k_rp * DKT + 8 * (t < 256 ? k_ch1 : k_ch0)) * 2u, vo0 = (unsigned)(2 * v_rp * ZW + 8 * (t < 128 ? v_ch : 0)) * 2u;
#define GLA_PREFETCH(s_) do { const char* qb_ = (const char*)qg + (size_t)(s_) * 32 * DKT * 2; const char* kb_ = (const char*)kg + (size_t)(s_) * 32 * DKT * 2; const char* vb_ = (const char*)vg + (size_t)(s_) * 32 * ZW * 2; \
            pq[0] = *(const v4u*)(qb_ + qo0); pq[1] = *(const v4u*)(qb_ + qo1); pq[2] = *(const v4u*)(qb_ + qo2); \
            pk[0] = *(const v4u*)(kb_ + ko0); pk[1] = *(const v4u*)(kb_ + ko0 + DKT * 2); \
            pk[2] = *(const v4u*)(kb_ + ko1); pk[3] = *(const v4u*)(kb_ + ko1 + DKT * 2); \
            pv[0] = *(const v4u*)(vb_ + vo0); pv[1] = *(const v4u*)(vb_ + vo0 + ZW * 2); } while (0)
        GLA_PREFETCH(0);
#pragma unroll 1
        for (int s = 0; s < 64; ++s) {
#pragma unroll
            for (int q = 0; q < 3; ++q) *(LAS v4u*)(L + GL_QL + q_row[q] * 768 + 16 * (q_ch[q] ^ (q_row[q] & 15))) = pq[q];
            {
                const int r0 = 2 * k_rp, r1 = 2 * k_rp + 1;
                *(LAS v4u*)(L + GL_KL + r0 * 768 + 16 * (k_ch0 ^ (r0 & 15))) = pk[0];
                *(LAS v4u*)(L + GL_KL + r1 * 768 + 16 * (k_ch0 ^ (r1 & 15))) = pk[1];
                const unsigned a0[4] = {pk[0].x, pk[0].y, pk[0].z, pk[0].w}, a1[4] = {pk[1].x, pk[1].y, pk[1].z, pk[1].w};
#pragma unroll
                for (int jj = 0; jj < 4; ++jj) {
                    *(LAS unsigned*)(L + GL_KT + (8 * k_ch0 + 2 * jj) * 72 + 4 * k_rp) = (a0[jj] & 0xffffu) | (a1[jj] << 16);
                    *(LAS unsigned*)(L + GL_KT + (8 * k_ch0 + 2 * jj + 1) * 72 + 4 * k_rp) = (a0[jj] >> 16) | (a1[jj] & 0xffff0000u); }
                if (t < 256) {
                    *(LAS v4u*)(L + GL_KL + r0 * 768 + 16 * (k_ch1 ^ (r0 & 15))) = pk[2];
                    *(LAS v4u*)(L + GL_KL + r1 * 768 + 16 * (k_ch1 ^ (r1 & 15))) = pk[3];
                    const unsigned b0[4] = {pk[2].x, pk[2].y, pk[2].z, pk[2].w}, b1[4] = {pk[3].x, pk[3].y, pk[3].z, pk[3].w};
#pragma unroll
                    for (int jj = 0; jj < 4; ++jj) {
                        *(LAS unsigned*)(L + GL_KT + (8 * k_ch1 + 2 * jj) * 72 + 4 * k_rp) = (b0[jj] & 0xffffu) | (b1[jj] << 16);
                        *(LAS unsigned*)(L + GL_KT + (8 * k_ch1 + 2 * jj + 1) * 72 + 4 * k_rp) = (b0[jj] >> 16) | (b1[jj] & 0xffff0000u); }
                }
                if (t < 128) {
                    const unsigned c0[4] = {pv[0].x, pv[0].y, pv[0].z, pv[0].w}, c1[4] = {pv[1].x, pv[1].y, pv[1].z, pv[1].w};
#pragma unroll
                    for (int jj = 0; jj < 4; ++jj) {
                        *(LAS unsigned*)(L + GL_VT + (8 * v_ch + 2 * jj) * 72 + 4 * v_rp) = (c0[jj] & 0xffffu) | (c1[jj] << 16);
                        *(LAS unsigned*)(L + GL_VT + (8 * v_ch + 2 * jj + 1) * 72 + 4 * v_rp) = (c0[jj] >> 16) | (c1[jj] & 0xffff0000u); }
                }
            }
            f32x4 ebv[3][2];
            { const float* eb = C.EBL + (size_t)(b * 64 + s) * DKT + h * DKH;
#pragma unroll
                for (int p = 0; p < 3; ++p)
#pragma unroll
                    for (int hf = 0; hf < 2; ++hf) ebv[p][hf] = *(const f32x4*)(eb + 32 * (3 * dg + p) + 16 * hf + 4 * g); }
            __builtin_amdgcn_sched_barrier(0);
            GLA_PREFETCH(s + 1 < 64 ? s + 1 : 63);
            __builtin_amdgcn_sched_barrier(0);
            asm volatile("s_waitcnt lgkmcnt(0)" ::: "memory"); __builtin_amdgcn_s_barrier(); asm volatile("" ::: "memory");
            if (w < 3) {
                const int it = (w >= 1) ? 1 : 0, jt = (w == 2) ? 1 : 0;
                f32x4 pa = (f32x4){0.f, 0.f, 0.f, 0.f};
                const int rj = 16 * jt + c, ri = 16 * it + c;
#pragma unroll
                for (int kb = 0; kb < 2; ++kb) {
                    bf16x8 af[6], bf[6];
#pragma unroll
                    for (int q = 0; q < 6; ++q) { const int ks = 6 * kb + q;
                        af[q] = *(const LAS bf16x8*)(L + GL_KL + rj * 768 + 16 * ((4 * ks + g) ^ (rj & 15)));
                        bf[q] = *(const LAS bf16x8*)(L + GL_QL + ri * 768 + 16 * ((4 * ks + g) ^ (ri & 15))); }
                    __builtin_amdgcn_sched_barrier(0);
#pragma unroll
                    for (int q = 0; q < 6; ++q) pa = __builtin_amdgcn_mfma_f32_16x16x32_bf16(af[q], bf[q], pa, 0, 0, 0);
                    __builtin_amdgcn_sched_barrier(0);
                }
                if (it == jt) {
#pragma unroll
                    for (int r = 0; r < 4; ++r) if (4 * g + r > c) pa[r] = 0.f;
                }
                v2u pw; pw.x = pg8::cvt_pk_bf16(pa[0], pa[1]); pw.y = pg8::cvt_pk_bf16(pa[2], pa[3]);
                *(LAS v2u*)(L + GL_P + ri * 72 + (16 * jt + 4 * g) * 2) = pw;
            }
            f32x4 O[2][2];
#pragma unroll
            for (int it = 0; it < 2; ++it)
#pragma unroll
                for (int et = 0; et < 2; ++et) O[it][et] = (f32x4){0.f, 0.f, 0.f, 0.f};
            {
                v2u qlo[3][2], qhi[3][2];
#pragma unroll
                for (int p = 0; p < 3; ++p) { const int cb = 4 * (3 * dg + p);
#pragma unroll
                    for (int it = 0; it < 2; ++it) { const int ri = 16 * it + c;
                        qlo[p][it] = *(const LAS v2u*)(L + GL_QL + ri * 768 + 16 * ((cb + (g >> 1)) ^ (ri & 15)) + 8 * (g & 1));
                        qhi[p][it] = *(const LAS v2u*)(L + GL_QL + ri * 768 + 16 * ((cb + 2 + (g >> 1)) ^ (ri & 15)) + 8 * (g & 1)); } }
                bf16x8 Bf[3][2];
#pragma unroll
                for (int p = 0; p < 3; ++p)
#pragma unroll
                    for (int et = 0; et < 2; ++et) { v4u x; x.x = pg8::cvt_pk_bf16(R[p][0][et][0], R[p][0][et][1]); x.y = pg8::cvt_pk_bf16(R[p][0][et][2], R[p][0][et][3]);
                        x.z = pg8::cvt_pk_bf16(R[p][1][et][0], R[p][1][et][1]); x.w = pg8::cvt_pk_bf16(R[p][1][et][2], R[p][1][et][3]); Bf[p][et] = __builtin_bit_cast(bf16x8, x); }
                __builtin_amdgcn_sched_barrier(0);
#pragma unroll
                for (int p = 0; p < 3; ++p)
#pragma unroll
                    for (int it = 0; it < 2; ++it) { const bf16x8 a = mk_frag(qlo[p][it], qhi[p][it]);
#pragma unroll
                        for (int et = 0; et < 2; ++et) O[it][et] = __builtin_amdgcn_mfma_f32_16x16x32_bf16(a, Bf[p][et], O[it][et], 0, 0, 0); }
            }
            asm volatile("s_waitcnt lgkmcnt(0)" ::: "memory"); __builtin_amdgcn_s_barrier(); asm volatile("" ::: "memory");
            bf16x8 Vf[2];
#pragma unroll
            for (int et = 0; et < 2; ++et) { const int e = 32 * eh + 16 * et + c;
                Vf[et] = mk_frag(*(const LAS v2u*)(L + GL_VT + e * 72 + 16 * g), *(const LAS v2u*)(L + GL_VT + e * 72 + 16 * g + 8)); }
            if (dg == 0) {
#pragma unroll
                for (int it = 0; it < 2; ++it) { const int ri = 16 * it + c;
                    const bf16x8 a = mk_frag(*(const LAS v2u*)(L + GL_P + ri * 72 + 16 * g), *(const LAS v2u*)(L + GL_P + ri * 72 + 16 * g + 8));
#pragma unroll
                    for (int et = 0; et < 2; ++et) O[it][et] = __builtin_amdgcn_mfma_f32_16x16x32_bf16(a, Vf[et], O[it][et], 0, 0, 0); }
            }
#pragma unroll
            for (int it = 0; it < 2; ++it)
#pragma unroll
                for (int et = 0; et < 2; ++et)
#pragma unroll
                    for (int r = 0; r < 4; ++r) *(LAS float*)(L + GL_OS + ((dg * 32 + 16 * it + 4 * g + r) * 64 + 32 * eh + 16 * et + c) * 4) = O[it][et][r];
            {
                v2u klo[3][2], khi[3][2];
#pragma unroll
                for (int p = 0; p < 3; ++p)
#pragma unroll
                    for (int hf = 0; hf < 2; ++hf) { const int d = 32 * (3 * dg + p) + 16 * hf + c;
                        klo[p][hf] = *(const LAS v2u*)(L + GL_KT + d * 72 + 16 * g); khi[p][hf] = *(const LAS v2u*)(L + GL_KT + d * 72 + 16 * g + 8); }
                __builtin_amdgcn_sched_barrier(0);
#pragma unroll
                for (int p = 0; p < 3; ++p)
#pragma unroll
                    for (int hf = 0; hf < 2; ++hf) { const bf16x8 a = mk_frag(klo[p][hf], khi[p][hf]);
#pragma unroll
                        for (int et = 0; et < 2; ++et) R[p][hf][et] = __builtin_amdgcn_mfma_f32_16x16x32_bf16(a, Vf[et], R[p][hf][et], 0, 0, 0); }
            }
            asm volatile("s_waitcnt lgkmcnt(0)" ::: "memory"); __builtin_amdgcn_s_barrier(); asm volatile("" ::: "memory");
            { const int i = t >> 4, e4 = (t & 15) * 4;
                f32x4 o = *(const LAS f32x4*)(L + GL_OS + ((0 * 32 + i) * 64 + e4) * 4);
#pragma unroll
                for (int q = 1; q < 4; ++q) o += *(const LAS f32x4*)(L + GL_OS + ((q * 32 + i) * 64 + e4) * 4);
                *(v2u*)(C.OB + (size_t)(b * SEQ + 32 * s + i) * DVT + h * DVH + 64 * es + e4) = (v2u){pg8::cvt_pk_bf16(o.x, o.y), pg8::cvt_pk_bf16(o.z, o.w)}; }
#pragma unroll
            for (int p = 0; p < 3; ++p)
#pragma unroll
                for (int hf = 0; hf < 2; ++hf)
#pragma unroll
                    for (int et = 0; et < 2; ++et) R[p][hf][et] *= ebv[p][hf];
        }
#undef GLA_PREFETCH
#pragma unroll
        for (int p = 0; p < 3; ++p)
#pragma unroll
            for (int hf = 0; hf < 2; ++hf)
#pragma unroll
                for (int et = 0; et < 2; ++et)
#pragma unroll
                    for (int r = 0; r < 4; ++r)
                        C.out[OFF_GLAP + ((size_t)(b * 4 + h) * DKH + 32 * (3 * dg + p) + 16 * hf + 4 * g + r) * DVH + 64 * es + 32 * eh + 16 * et + c] = R[p][hf][et][r];
        __syncthreads();
    }
}

__device__ __forceinline__ void p6_finalize(const Ctx& C) {
    const int lane = lane_fresh();
    const bool hi = lane >= 32;
    auto do_row = [&](int row) {
        const v4u* op = (const v4u*)(C.OB + (size_t)row * DVT) + lane;
        const v4u* gp = (const v4u*)(C.Z + (size_t)row * ZW + ZC_G) + lane;
        v4u ov[6], gv[6];
#pragma unroll
        for (int jj = 0; jj < 6; ++jj) ov[jj] = op[64 * jj];
#pragma unroll
        for (int jj = 0; jj < 6; ++jj) gv[jj] = gp[64 * jj];
        float ss[6];
#pragma unroll
        for (int jj = 0; jj < 6; ++jj) { const float a0 = bflo(ov[jj].x), a1 = bfhi(ov[jj].x), a2 = bflo(ov[jj].y), a3 = bfhi(ov[jj].y), a4 = bflo(ov[jj].z), a5 = bfhi(ov[jj].z), a6 = bflo(ov[jj].w), a7 = bfhi(ov[jj].w);
            ss[jj] = ((a0 * a0 + a1 * a1) + (a2 * a2 + a3 * a3)) + ((a4 * a4 + a5 * a5) + (a6 * a6 + a7 * a7)); }
        const float q0 = wave_sum(ss[0] + (hi ? 0.f : ss[1])), q1 = wave_sum((hi ? ss[1] : 0.f) + ss[2]), q2 = wave_sum(ss[3] + (hi ? 0.f : ss[4])), q3 = wave_sum((hi ? ss[4] : 0.f) + ss[5]);
        const float r0 = 1.0f / sqrtf(q0 * (1.0f / DVH) + EPS), r1 = 1.0f / sqrtf(q1 * (1.0f / DVH) + EPS), r2 = 1.0f / sqrtf(q2 * (1.0f / DVH) + EPS), r3 = 1.0f / sqrtf(q3 * (1.0f / DVH) + EPS);
        v4u* mp = (v4u*)(C.MIX + (size_t)row * D + DPOOL) + lane;
#pragma unroll
        for (int jj = 0; jj < 6; ++jj) {
            const float rs = jj == 0 ? r0 : jj == 1 ? (hi ? r1 : r0) : jj == 2 ? r1 : jj == 3 ? r2 : jj == 4 ? (hi ? r3 : r2) : r3;
            const float* gn = C.g_gla_out + 8 * (64 * jj + lane);
            const f32x4 g0 = *(const f32x4*)gn, g1 = *(const f32x4*)(gn + 4);
            const float y0 = pg8::silu_f(bflo(gv[jj].x)) * (bflo(ov[jj].x) * rs * g0.x), y1 = pg8::silu_f(bfhi(gv[jj].x)) * (bfhi(ov[jj].x) * rs * g0.y);
            const float y2 = pg8::silu_f(bflo(gv[jj].y)) * (bflo(ov[jj].y) * rs * g0.z), y3 = pg8::silu_f(bfhi(gv[jj].y)) * (bfhi(ov[jj].y) * rs * g0.w);
            const float y4 = pg8::silu_f(bflo(gv[jj].z)) * (bflo(ov[jj].z) * rs * g1.x), y5 = pg8::silu_f(bfhi(gv[jj].z)) * (bfhi(ov[jj].z) * rs * g1.y);
            const float y6 = pg8::silu_f(bflo(gv[jj].w)) * (bflo(ov[jj].w) * rs * g1.z), y7 = pg8::silu_f(bfhi(gv[jj].w)) * (bfhi(ov[jj].w) * rs * g1.w);
            mp[64 * jj] = (v4u){pk2(y0, y1), pk2(y2, y3), pk2(y4, y5), pk2(y6, y7)}; }
    };
    for (int bi = (int)blockIdx.x; bi < TP / 32; bi += C.G)
#pragma unroll 1
        for (int k = 0; k < 4; ++k) do_row(32 * bi + C.wave + 8 * k);
    for (int n = (int)blockIdx.x; n < NS; n += C.G) if (C.wave == (n & 7)) do_row(TP + n);
}

__device__ __forceinline__ void p11_final_norm(const Ctx& C) {
    const int lane = lane_fresh();
    auto do_row = [&](int row) {
        const v4u* xv = (const v4u*)(C.OPB + (size_t)row * D) + lane;
        v4u w[8]; float s = 0.f;
#pragma unroll
        for (int j = 0; j < 8; ++j) w[j] = xv[64 * j];
#pragma unroll
        for (int j = 0; j < 8; ++j) { const float a0 = bflo(w[j].x), a1 = bfhi(w[j].x), a2 = bflo(w[j].y), a3 = bfhi(w[j].y), a4 = bflo(w[j].z), a5 = bfhi(w[j].z), a6 = bflo(w[j].w), a7 = bfhi(w[j].w);
            s += ((a0 * a0 + a1 * a1) + (a2 * a2 + a3 * a3)) + ((a4 * a4 + a5 * a5) + (a6 * a6 + a7 * a7)); }
        const float rstd = 1.0f / sqrtf(wave_sum(s) * (1.0f / D) + EPS);
        float* orow = C.out + (size_t)row * D;
#pragma unroll
        for (int j = 0; j < 8; ++j) { const int c = 8 * (64 * j + lane);
            const f32x4 g0 = *(const f32x4*)(C.g_final + c), g1 = *(const f32x4*)(C.g_final + c + 4);
            const f32x4 x0 = (f32x4){bflo(w[j].x), bfhi(w[j].x), bflo(w[j].y), bfhi(w[j].y)}, x1 = (f32x4){bflo(w[j].z), bfhi(w[j].z), bflo(w[j].w), bfhi(w[j].w)};
            *(f32x4*)(orow + c) = x0 * rstd * g0; *(f32x4*)(orow + c + 4) = x1 * rstd * g1; }
    };
    for (int bi = (int)blockIdx.x; bi < TP / 32; bi += C.G)
#pragma unroll 1
        for (int k = 0; k < 4; ++k) do_row(32 * bi + C.wave + 8 * k);
    const int t = threadIdx.x, w = C.wave;
    for (int n = blockIdx.x; n < NS; n += C.G) {
        const int row = TP + n;
        f32x4 v[2]; float ssq;
        sample_row_from_slabs<16>(C.X1 + (size_t)row * D, C.MOD + (size_t)(4 + n) * NMOD + 5 * D, C.XS, n, v, ssq, (LAS float*)C.lds, t, w);
        const float rstd = 1.0f / sqrtf(ssq * (1.0f / D) + EPS);
#pragma unroll
        for (int j = 0; j < 2; ++j) { const int c = 4 * t + 2048 * j;
            *(f32x4*)(C.out + (size_t)row * D + c) = v[j] * rstd * *(const f32x4*)(C.g_final + c); }
    }
}

__device__ __forceinline__ void p9_fixup(const Ctx& C) {
    const int nth = C.G * NWAVES * 64;
    for (int it = blockIdx.x * NWAVES * 64 + threadIdx.x; it < NS * (OV_COLS / 8); it += nth) {
        const int n = it / (OV_COLS / 8), col = (it % (OV_COLS / 8)) * 8;
        f32x4 a0 = (f32x4){0.f, 0.f, 0.f, 0.f}, a1 = a0, b0 = a0, b1 = a0;
#pragma unroll
        for (int ks = 0; ks < OV_KS; ++ks) { const float* pa = C.SS + ((size_t)(ks * 2) * NS + n) * OV_COLS + col; const float* pb = pa + (size_t)NS * OV_COLS;
            a0 += *(const f32x4*)pa; a1 += *(const f32x4*)(pa + 4); b0 += *(const f32x4*)pb; b1 += *(const f32x4*)(pb + 4); }
        v4u w;
        w.x = pg8::cvt_pk_bf16(pg8::silu_f(a0.x) * b0.x, pg8::silu_f(a0.y) * b0.y); w.y = pg8::cvt_pk_bf16(pg8::silu_f(a0.z) * b0.z, pg8::silu_f(a0.w) * b0.w);
        w.z = pg8::cvt_pk_bf16(pg8::silu_f(a1.x) * b1.x, pg8::silu_f(a1.y) * b1.y); w.w = pg8::cvt_pk_bf16(pg8::silu_f(a1.z) * b1.z, pg8::silu_f(a1.w) * b1.w);
        const int blk = col >> 7, pn = blk < OV_N / 2 ? OV_PA + blk : OV_PB + blk;
        *(v4u*)(C.ACT + (size_t)(TP + n) * DFF + pn * 128 + (col & 127)) = w;
    }
}

struct Args { const float* in[21]; float* out; unsigned char* ws; int ph_lo, ph_hi, li, pad; };
__global__ void __launch_bounds__(NWAVES * 64, 2) fwd_kernel(Args args) {
    extern __shared__ __attribute__((aligned(16))) unsigned char lds[];
    Ctx C;
    C.lds = (LAS unsigned char*)lds;
    C.wave = __builtin_amdgcn_readfirstlane(threadIdx.x >> 6);
    C.G = gridDim.x; C.gw = blockIdx.x * NWAVES + C.wave; C.NGW = C.G * NWAVES;
    C.x_prompt = args.in[0]; C.x_sample = args.in[1]; C.state_pool = args.in[2]; C.state_gla = args.in[3]; C.c_prompt = args.in[4]; C.c_sample = args.in[5];
    C.w_ada = args.in[6]; C.b_ada = args.in[7]; C.g_norm1 = args.in[8]; C.w_in = args.in[9]; C.w_pool = args.in[10]; C.pool_scale = args.in[11]; C.w_a2 = args.in[12];
    C.b_a = args.in[13]; C.g_gla_out = args.in[14]; C.w_out = args.in[15]; C.g_norm2 = args.in[16]; C.w_ff1 = args.in[17]; C.w_ff3 = args.in[18]; C.w_ff2 = args.in[19]; C.g_final = args.in[20];
    C.out = args.out;
    unsigned char* ws = args.ws;
    C.MOD = (float*)(ws + WS_MOD); C.SC = (bf16*)(ws + WS_SC); C.WinT = (bf16*)(ws + WS_WIN); C.WaT = (bf16*)(ws + WS_WA); C.WoutT = (bf16*)(ws + WS_WOUT);
    C.W13T = (bf16*)(ws + WS_W13); C.Wff2T = (bf16*)(ws + WS_WFF2); C.WpT = (bf16*)(ws + WS_WP); C.H = (bf16*)(ws + WS_H); C.Z = (bf16*)(ws + WS_Z);
    C.QT = (bf16*)(ws + WS_QT); C.KT = (bf16*)(ws + WS_KT); C.EBL = (float*)(ws + WS_EBL); C.LAS_ = (float*)(ws + WS_LAS); C.DP = (bf16*)(ws + WS_DP);
    C.OB = (bf16*)(ws + WS_OB); C.MIX = (bf16*)(ws + WS_MIX); C.X1 = (float*)(ws + WS_X1); C.X1B = (bf16*)(ws + WS_X1); C.OPB = (bf16*)(ws + WS_X1 + (size_t)TP * D * 2); C.ACT = (bf16*)(ws + WS_ACT); C.ZS = (float*)(ws + WS_ZS); C.XS = (float*)(ws + WS_XS); C.SS = (float*)(ws + WS_SS);
    volatile LAS unsigned* MISC = (volatile LAS unsigned*)(C.lds + MISC_OFF);
    for (int u = threadIdx.x; u < (LDS_BYTES - MISC_OFF) / 4; u += NWAVES * 64) MISC[u] = 0u;
    __syncthreads();
    unsigned* ctl = (unsigned*)(ws + WS_CTL);
    XcdBarrier bar; bar.bar = ctl + CW_BAR; bar.x = 0; bar.st = nullptr;
    if (MK_LAUNCHES == 1) bar = xcd_barrier_post(ctl + CW_BAR, MISC + 8);
#define GRID_BAR() do { if (MK_LAUNCHES == 1) xcd_barrier(bar); } while (0)
    const int lo = args.ph_lo, hi = args.ph_hi;
#define IN(k) (lo <= (k) && (k) < hi)
#define BOTH(k) (IN(k) && IN((k) + 1))

#define DUP(k) ((PROBE_DUP >> (k)) & 1)
    if (IN(0)) { p0_small(C); if (BOTH(0)) GRID_BAR(); }
    if (IN(1)) { p1_adaln(C); if (DUP(1)) { GRID_BAR(); p1_adaln(C); } for (int rr = 0; rr < PROBE_REP1; ++rr) { GRID_BAR(); p1_adaln(C); } if (BOTH(1)) GRID_BAR(); }
    if (IN(2)) { norm_rows<false>(C, C.x_prompt, nullptr, C.x_sample, C.g_norm1, 0, D, C.H, nullptr, 0, nullptr); if (DUP(2)) { GRID_BAR(); norm_rows<false>(C, C.x_prompt, nullptr, C.x_sample, C.g_norm1, 0, D, C.H, nullptr, 0, nullptr); } if (BOTH(2)) GRID_BAR(); }
    if (IN(3)) {
        pg8::Gemm g{C.H, C.WinT, D, D, 0}; pg8::TwoPartOrder S; S.init(TP / 256, ZW / 256, D / 64, 4, 16, 16, 4, C.G, (int)blockIdx.x);
        pg8::EpiZ E{C.Z, ZW, C.ZS};
        pg8::gemm_phase<pg8::EpiZ, pg8::TwoPartOrder, true, true>(C.lds, g, S, E);
        if (DUP(3)) { GRID_BAR(); pg8::gemm_phase<pg8::EpiZ, pg8::TwoPartOrder, true, true>(C.lds, g, S, E); }
        if (BOTH(3)) GRID_BAR();
    }
    if (IN(4)) { p4_prep(C); if (DUP(4)) { GRID_BAR(); p4_prep(C); } if (BOTH(4)) GRID_BAR(); }
    if (IN(5)) { p5_gla_prompt(C); if (DUP(5)) { GRID_BAR(); p5_gla_prompt(C); } p5_sample_pool(C); p5_gla_sample_q(C, ctl + CW_Q); if (BOTH(5)) GRID_BAR(); }
    if (IN(6)) {
        p6_finalize(C);
        for (int rr = 0; rr < PROBE_REP6; ++rr) { GRID_BAR(); p6_finalize(C); }
        __syncthreads();
        pg8::Gemm g{C.DP, C.WpT, DPOOL, 256, 256}; pg8::TwoPartOrder S; S.init(MP / 256, 4, 4, 0, 0, 0, 0, C.G, (int)blockIdx.x);
        pg8::EpiPool E{C.MIX, D, C.pool_scale};
        pg8::gemm_phase<pg8::EpiPool, pg8::TwoPartOrder, true, true>(C.lds, g, S, E);
        if (DUP(6)) { GRID_BAR(); p6_finalize(C); __syncthreads(); pg8::gemm_phase<pg8::EpiPool, pg8::TwoPartOrder, true, true>(C.lds, g, S, E); }
        if (BOTH(6)) GRID_BAR();
    }
    if (IN(7)) {
        pg8::Gemm g{C.MIX, C.WoutT, D, D, 0}; pg8::TwoPartOrder S; S.init(TP / 256, D / 256, D / 64, 8, 8, 8, 8, C.G, (int)blockIdx.x);
        pg8::EpiResB<false> E{C.x_prompt, nullptr, C.MOD + 2 * D, C.X1B, C.XS};
        pg8::gemm_phase<pg8::EpiResB<false>, pg8::TwoPartOrder, true, true>(C.lds, g, S, E);
        if (DUP(7)) { GRID_BAR(); pg8::gemm_phase<pg8::EpiResB<false>, pg8::TwoPartOrder, true, true>(C.lds, g, S, E); }
        if (BOTH(7)) GRID_BAR();
    }
    if (IN(8)) { norm_rows<true>(C, nullptr, C.X1B, C.x_sample, C.g_norm2, 3 * D, 4 * D, C.H, C.XS, 2 * D, C.X1); if (DUP(8)) { GRID_BAR(); norm_rows<true>(C, nullptr, C.X1B, C.x_sample, C.g_norm2, 3 * D, 4 * D, C.H, C.XS, 2 * D, C.X1); } if (BOTH(8)) GRID_BAR(); }
    if (IN(9)) {
        pg8::Gemm g{C.H, C.W13T, D, D, 0}; pg8::TwoPartOrder S; S.init(TP / 256, 2 * DFF / 256, D / 64, 1, D / 64, D / 64, 1, C.G, (int)blockIdx.x); S.ovf = (C.G == 256) ? OV_KS : 0;
        pg8::EpiSwiGLU E{C.ACT, DFF, C.SS, OV_SPLIT, OV_PA, OV_PB, OV_COLS};
        pg8::gemm_phase<pg8::EpiSwiGLU, pg8::TwoPartOrder, true, true>(C.lds, g, S, E);
        if (DUP(9)) { GRID_BAR(); pg8::gemm_phase<pg8::EpiSwiGLU, pg8::TwoPartOrder, true, true>(C.lds, g, S, E); }
        if (BOTH(9)) GRID_BAR();
    }
    if (IN(10) && C.G == 256) { p9_fixup(C); GRID_BAR(); }
    if (IN(10)) {
        pg8::Gemm g{C.ACT, C.Wff2T, DFF, DFF, 0}; pg8::TwoPartOrder S; S.init(TP / 256, D / 256, DFF / 64, 16, 12, 10, 6, C.G, (int)blockIdx.x, C.G == 256 ? 1 : 0);
        pg8::EpiResB<true> E{nullptr, C.X1B, C.MOD + 5 * D, C.OPB, C.XS};
        pg8::gemm_phase<pg8::EpiResB<true>, pg8::TwoPartOrder, true, true>(C.lds, g, S, E);
        if (DUP(10)) { GRID_BAR(); pg8::gemm_phase<pg8::EpiResB<true>, pg8::TwoPartOrder, true, true>(C.lds, g, S, E); }
        if (BOTH(10)) GRID_BAR();
    }
    if (IN(11)) { p11_final_norm(C); }
#undef IN
#undef BOTH
}

extern "C" void kernel_launch(void* const* d_in, const int* in_sizes, int n_in, void* d_out, int out_size, void* d_ws, size_t ws_size, hipStream_t stream) {
    static int grid = 0;
    if (grid == 0) {
        if (n_in != 21 || ws_size < WS_END) { fprintf(stderr, "kernel_launch: unexpected shapes (n_in %d, ws %zu < %zu)\n", n_in, ws_size, (size_t)WS_END); grid = -1; return; }
        int dev = 0, cus = 0, per_cu = 0;
        if (hipGetDevice(&dev) != hipSuccess || hipDeviceGetAttribute(&cus, hipDeviceAttributeMultiprocessorCount, dev) != hipSuccess) { grid = -1; return; }
        if (hipFuncSetAttribute((const void*)fwd_kernel, hipFuncAttributeMaxDynamicSharedMemorySize, LDS_BYTES) != hipSuccess) { fprintf(stderr, "kernel_launch: hipFuncSetAttribute failed\n"); grid = -1; return; }
        if (hipOccupancyMaxActiveBlocksPerMultiprocessor(&per_cu, (const void*)fwd_kernel, NWAVES * 64, LDS_BYTES) != hipSuccess || per_cu < 1)
            fprintf(stderr, "kernel_launch: occupancy query reports %d workgroups per CU\n", per_cu);
        (void)hipGetLastError();
        grid = cus;
    }
    if (grid < 0) return;
    if (hipMemsetAsync((char*)d_ws + WS_CTL, 0, CTL_ZERO_BYTES, stream) != hipSuccess) return;
    Args a{};
    for (int i = 0; i < 21; ++i) a.in[i] = (const float*)d_in[i];
    a.out = (float*)d_out; a.ws = (unsigned char*)d_ws; a.pad = 0;
    for (int li = 0; li < MK_LAUNCHES; ++li) {
        if (MK_LAUNCHES == 1) { a.ph_lo = 0; a.ph_hi = NPHASES; } else { a.ph_lo = li; a.ph_hi = li + 1; }
        a.li = li;
        hipLaunchKernelGGL(fwd_kernel, dim3(grid), dim3(NWAVES * 64), LDS_BYTES, stream, a);
        if (hipPeekAtLastError() != hipSuccess) { fprintf(stderr, "kernel_launch: launch %d failed\n", li); break; }
    }
}
```
